# Optimizing an MI355X kernel written in HIP

```python
import math
import jax, jax.numpy as jnp
from jax import lax
import numpy as np

D_MODEL = 1024
BATCH = 32
SEQ = 256
DEPTH = 2
DEC_BATCH = 4
DEC_SEQ = 4096
PAST_LEN = 256

GRID_W = 64
N_EVEN = (DEPTH + 1) // 2
N_ODD = DEPTH // 2
MLA_HEADS = 8
Q_LORA = 384
KV_LORA = 256
QK_NOPE = 64
QK_ROPE = 32
QK_HEAD = QK_NOPE + QK_ROPE
V_HEAD = 64
ROPE_THETA = 10000.0
Q_BLOCK = 128
GLA_HEADS = 4
GLA_DK = 64
GLA_DV = 128
ALPHA_RANK = 16
GLA_TAU = 16.0
GLA_CHUNK = 64
CONV_WIDTH = 31
CONV_PAD = CONV_WIDTH // 2
FFN_HIDDEN = ((8 * D_MODEL // 3 + 255) // 256) * 256
MIX_OUT = MLA_HEADS * V_HEAD + GLA_HEADS * GLA_DV
IN_SPLITS = (Q_LORA, KV_LORA, QK_ROPE, GLA_HEADS * GLA_DK, GLA_HEADS * GLA_DK,
             GLA_HEADS * GLA_DV, GLA_HEADS * GLA_DV, 2 * ALPHA_RANK)
IN_WIDTH = sum(IN_SPLITS)
EPS = 1e-6

kernel_name = 'hybrid_mla_gla_conformer_dit_step'


def rmsnorm(x, g):
    xf = x.astype(jnp.float32)
    y = xf * lax.rsqrt(jnp.mean(xf * xf, axis=-1, keepdims=True) + EPS)
    return (y * g.astype(jnp.float32)).astype(x.dtype)


def layernorm(x, g, b):
    xf = x.astype(jnp.float32)
    mu = jnp.mean(xf, axis=-1, keepdims=True)
    var = jnp.mean(jnp.square(xf - mu), axis=-1, keepdims=True)
    y = (xf - mu) * lax.rsqrt(var + EPS)
    return (y * g.astype(jnp.float32) + b.astype(jnp.float32)).astype(x.dtype)


def ada_params(cvec, w, b):
    m = jax.nn.silu(cvec) @ w + b
    m = m.reshape(m.shape[:-1] + (6, D_MODEL))
    if m.ndim == 3:
        m = m[:, None]
    return [m[..., i, :] for i in range(6)]


def modulate(x, g, shift, scale):
    return rmsnorm(x, g) * (1 + scale) + shift


def axial_rope_angles(n_tokens):
    rows = n_tokens // GRID_W
    r = jnp.repeat(jnp.arange(rows), GRID_W).astype(jnp.float32)
    col = jnp.tile(jnp.arange(GRID_W), rows).astype(jnp.float32)
    half = QK_ROPE // 2
    inv_freq = ROPE_THETA ** (-jnp.arange(0, half, 2, dtype=jnp.float32) / half)
    return r[:, None] * inv_freq[None, :], col[:, None] * inv_freq[None, :]


def rotate(x, ang):
    m = ang.shape[-1]
    cos = jnp.cos(ang)[:, None, :].astype(x.dtype)
    sin = jnp.sin(ang)[:, None, :].astype(x.dtype)
    x1, x2 = x[..., :m], x[..., m:]
    return jnp.concatenate([x1 * cos - x2 * sin, x2 * cos + x1 * sin], axis=-1)


def apply_axial_rope(x, angles):
    ang_r, ang_c = angles
    h = QK_ROPE // 2
    return jnp.concatenate([rotate(x[..., :h], ang_r), rotate(x[..., h:], ang_c)], axis=-1)


def blocked_attend(q, k, v):
    b, lq, h, d = q.shape
    nb = lq // Q_BLOCK
    scale = 1.0 / math.sqrt(d)
    qb = q.reshape(b, nb, Q_BLOCK, h, d).transpose(1, 0, 2, 3, 4)

    def one_block(qi):
        s = jnp.einsum('bqhd,bkhd->bhqk', qi, k).astype(jnp.float32) * scale
        p = jax.nn.softmax(s, axis=-1).astype(v.dtype)
        return jnp.einsum('bhqk,bkhd->bqhd', p, v)

    o = lax.map(one_block, qb)
    return o.transpose(1, 0, 2, 3, 4).reshape(b, lq, h * v.shape[-1])


def gla_scan(q, k, v, log_a, s0):
    b, l, h, dk = q.shape
    dv = v.shape[-1]
    nc = l // GLA_CHUNK

    def chunks(t):
        return t.astype(jnp.float32).reshape(b, nc, GLA_CHUNK, h, t.shape[-1]).transpose(1, 0, 3, 2, 4)

    causal = jnp.tril(jnp.ones((GLA_CHUNK, GLA_CHUNK), dtype=bool))[:, :, None]

    def step(state, inp):
        qc, kc, vc, gc = inp
        cum = jnp.cumsum(gc, axis=2)
        decay = jnp.exp(jnp.where(causal, cum[:, :, :, None, :] - cum[:, :, None, :, :], -jnp.inf))
        scores = jnp.einsum('bhid,bhjd,bhijd->bhij', qc, kc, decay)
        o = jnp.einsum('bhij,bhjv->bhiv', scores, vc) + jnp.einsum('bhid,bhdv->bhiv', qc * jnp.exp(cum), state)
        last = cum[:, :, -1, :]
        state = jnp.exp(last)[..., None] * state + jnp.einsum(
            'bhjd,bhjv->bhdv', kc * jnp.exp(last[:, :, None, :] - cum), vc)
        return state, o

    s_fin, o = lax.scan(step, s0.astype(jnp.float32), (chunks(q), chunks(k), chunks(v), chunks(log_a)))
    o = o.transpose(1, 0, 3, 2, 4).reshape(b, l, h, dv)
    return o.astype(v.dtype), s_fin


def gla_bidir(q, k, v, la_f, la_b, s0_f, s0_b):
    flip = lambda t: jnp.flip(t, axis=1)
    o_f, s_f = gla_scan(q, k, v, la_f, s0_f)
    o_b, s_b = gla_scan(flip(q), flip(k), flip(v), flip(la_b), s0_b)
    return o_f + flip(o_b), s_f, s_b


def split_in(proj):
    outs, start = [], 0
    for w in IN_SPLITS:
        outs.append(proj[..., start:start + w])
        start += w
    return outs


def mla_queries(cq, qa_norm, w_uq, q_gain, angles):
    b, l, _ = cq.shape
    q = (rmsnorm(cq, qa_norm) @ w_uq).reshape(b, l, MLA_HEADS, QK_HEAD)
    q = rmsnorm(q, q_gain)
    if angles is not None:
        q = jnp.concatenate([q[..., :QK_NOPE], apply_axial_rope(q[..., QK_NOPE:], angles)], axis=-1)
    return q


def mla_keys_values(ckv_n, krope, w_ukv, k_gain, angles):
    b, l, _ = ckv_n.shape
    kv = (ckv_n @ w_ukv).reshape(b, l, MLA_HEADS, QK_NOPE + V_HEAD)
    k_pe = jnp.broadcast_to(krope[:, :, None, :], (b, l, MLA_HEADS, QK_ROPE))
    k = rmsnorm(jnp.concatenate([kv[..., :QK_NOPE], k_pe], axis=-1), k_gain)
    if angles is not None:
        k = jnp.concatenate([k[..., :QK_NOPE], apply_axial_rope(k[..., QK_NOPE:], angles)], axis=-1)
    return k, kv[..., QK_NOPE:]


def even_mixer(h, p, j, angles, ctx):
    b, l, _ = h.shape
    cq, ckv, krope, gq, gk, gv, gg, ga = split_in(h @ p['w_in'][j])
    ckv_n = rmsnorm(ckv, p['kva_norm'][j])
    q = mla_queries(cq, p['qa_norm'][j], p['w_uq'][j], p['q_norm'][j], angles)
    k, v = mla_keys_values(ckv_n, krope, p['w_ukv'][j], p['k_norm'][j], angles)
    g_q = gq.reshape(b, l, GLA_HEADS, GLA_DK) * (GLA_DK ** -0.5)
    g_k = gk.reshape(b, l, GLA_HEADS, GLA_DK)
    g_v = gv.reshape(b, l, GLA_HEADS, GLA_DV)
    la = [jax.nn.log_sigmoid((ga[..., d * ALPHA_RANK:(d + 1) * ALPHA_RANK] @ p['w_alpha_up'][j, d]
                               + p['b_alpha'][j, d]).astype(jnp.float32)).reshape(b, l, GLA_HEADS, GLA_DK) / GLA_TAU
          for d in range(2)]
    if ctx is None:
        s0_f = jnp.zeros((b, GLA_HEADS, GLA_DK, GLA_DV), jnp.float32)
        s0_b = s0_f
    else:
        ckv_c, krope_c, s_c = ctx
        k_c, v_c = mla_keys_values(ckv_c, krope_c, p['w_ukv'][j], p['k_norm'][j], None)
        k = jnp.concatenate([k_c, k], axis=1)
        v = jnp.concatenate([v_c, v], axis=1)
        s0_f, s0_b = s_c[:, 0], s_c[:, 1]
    attn = blocked_attend(q, k, v)
    o, s_f, s_b = gla_bidir(g_q, g_k, g_v, la[0], la[1], s0_f, s0_b)
    gla_out = (rmsnorm(o, p['gla_norm'][j]) * jax.nn.silu(gg.reshape(b, l, GLA_HEADS, GLA_DV))).reshape(b, l, -1)
    out = jnp.concatenate([attn, gla_out], axis=-1) @ p['w_out'][j]
    if ctx is None:
        return out, (ckv_n, krope, jnp.stack([s_f, s_b], axis=1))
    return out, None


def conv_module(h, p, j):
    u = h @ p['conv_w_pw1'][j] + p['conv_b_pw1'][j]
    u = u[..., :D_MODEL] * jax.nn.sigmoid(u[..., D_MODEL:])
    u = lax.conv_general_dilated(u, p['conv_w_dw'][j][:, None, :], window_strides=(1,),
                                 padding=[(CONV_PAD, CONV_PAD)], dimension_numbers=('NWC', 'WIO', 'NWC'),
                                 feature_group_count=D_MODEL) + p['conv_b_dw'][j]
    u = jax.nn.silu(layernorm(u, p['conv_ln_g'][j], p['conv_ln_b'][j]))
    return u @ p['conv_w_pw2'][j] + p['conv_b_pw2'][j]


def swiglu(h, p, i):
    return (jax.nn.silu(h @ p['ffn_w_gate'][i]) * (h @ p['ffn_w_up'][i])) @ p['ffn_w_down'][i]


def run_trunk(x, cvec, p, angles, caches):
    ckv_l, kr_l, st_l = [], [], []
    for i in range(DEPTH):
        j = i // 2
        sh1, sc1, g1, sh2, sc2, g2 = ada_params(cvec, p['w_ada'][i], p['b_ada'][i])
        h = modulate(x, p['norm_mix'][i], sh1, sc1)
        if i % 2 == 0:
            ctx = None if caches is None else (caches[0][:, j], caches[1][:, j], caches[2][:, j])
            out, st = even_mixer(h, p, j, angles, ctx)
            if st is not None:
                ckv_l.append(st[0])
                kr_l.append(st[1])
                st_l.append(st[2])
        else:
            out = conv_module(h, p, j)
        x = x + g1 * out
        h = modulate(x, p['norm_ffn'][i], sh2, sc2)
        x = x + g2 * swiglu(h, p, i)
    return x, ckv_l, kr_l, st_l


def setup_inputs(seed: int = 0) -> dict:
    key = jax.random.key(seed)
    ks = list(jax.random.split(key, 40))

    def nrm(shape, scale=1.0):
        return jax.random.normal(ks.pop(), shape, jnp.float32) * scale

    def gain(shape):
        return 1.0 + nrm(shape, 0.1)

    D = D_MODEL
    return {
        'x_prompt': nrm((BATCH, SEQ, D)),
        'x_sample': nrm((DEC_BATCH, DEC_SEQ, D)),
        'cache_mla_ckv': nrm((DEC_BATCH, N_EVEN, PAST_LEN, KV_LORA)),
        'cache_mla_krope': nrm((DEC_BATCH, N_EVEN, PAST_LEN, QK_ROPE)),
        'state_gla': nrm((DEC_BATCH, N_EVEN, 2, GLA_HEADS, GLA_DK, GLA_DV)),
        'c': nrm((DEC_BATCH, D)),
        'c_ctx': nrm((D,)),
        'w_ada': nrm((DEPTH, D, 6 * D), 0.5 * D ** -0.5),
        'b_ada': nrm((DEPTH, 6 * D), 0.01),
        'norm_mix': gain((DEPTH, D)),
        'norm_ffn': gain((DEPTH, D)),
        'w_in': nrm((N_EVEN, D, IN_WIDTH), D ** -0.5),
        'qa_norm': gain((N_EVEN, Q_LORA)),
        'w_uq': nrm((N_EVEN, Q_LORA, MLA_HEADS * QK_HEAD), Q_LORA ** -0.5),
        'kva_norm': gain((N_EVEN, KV_LORA)),
        'w_ukv': nrm((N_EVEN, KV_LORA, MLA_HEADS * (QK_NOPE + V_HEAD)), KV_LORA ** -0.5),
        'q_norm': gain((N_EVEN, QK_HEAD)),
        'k_norm': gain((N_EVEN, QK_HEAD)),
        'w_alpha_up': nrm((N_EVEN, 2, ALPHA_RANK, GLA_HEADS * GLA_DK), ALPHA_RANK ** -0.5),
        'b_alpha': nrm((N_EVEN, 2, GLA_HEADS * GLA_DK), 0.1),
        'gla_norm': gain((N_EVEN, GLA_DV)),
        'w_out': nrm((N_EVEN, MIX_OUT, D), MIX_OUT ** -0.5),
        'conv_w_pw1': nrm((N_ODD, D, 2 * D), D ** -0.5),
        'conv_b_pw1': nrm((N_ODD, 2 * D), 0.01),
        'conv_w_dw': nrm((N_ODD, CONV_WIDTH, D), CONV_WIDTH ** -0.5),
        'conv_b_dw': nrm((N_ODD, D), 0.01),
        'conv_ln_g': gain((N_ODD, D)),
        'conv_ln_b': nrm((N_ODD, D), 0.01),
        'conv_w_pw2': nrm((N_ODD, D, D), D ** -0.5),
        'conv_b_pw2': nrm((N_ODD, D), 0.01),
        'ffn_w_gate': nrm((DEPTH, D, FFN_HIDDEN), D ** -0.5),
        'ffn_w_up': nrm((DEPTH, D, FFN_HIDDEN), D ** -0.5),
        'ffn_w_down': nrm((DEPTH, FFN_HIDDEN, D), FFN_HIDDEN ** -0.5),
    }


def reference(x_prompt, x_sample, cache_mla_ckv, cache_mla_krope, state_gla, c, c_ctx,
              w_ada, b_ada, norm_mix, norm_ffn, w_in, qa_norm, w_uq, kva_norm, w_ukv, q_norm, k_norm,
              w_alpha_up, b_alpha, gla_norm, w_out, conv_w_pw1, conv_b_pw1, conv_w_dw, conv_b_dw,
              conv_ln_g, conv_ln_b, conv_w_pw2, conv_b_pw2, ffn_w_gate, ffn_w_up, ffn_w_down):
    p = dict(w_ada=w_ada, b_ada=b_ada, norm_mix=norm_mix, norm_ffn=norm_ffn, w_in=w_in, qa_norm=qa_norm,
             w_uq=w_uq, kva_norm=kva_norm, w_ukv=w_ukv, q_norm=q_norm, k_norm=k_norm, w_alpha_up=w_alpha_up,
             b_alpha=b_alpha, gla_norm=gla_norm, w_out=w_out, conv_w_pw1=conv_w_pw1, conv_b_pw1=conv_b_pw1,
             conv_w_dw=conv_w_dw, conv_b_dw=conv_b_dw, conv_ln_g=conv_ln_g, conv_ln_b=conv_ln_b,
             conv_w_pw2=conv_w_pw2, conv_b_pw2=conv_b_pw2, ffn_w_gate=ffn_w_gate, ffn_w_up=ffn_w_up,
             ffn_w_down=ffn_w_down)
    y_prompt, ckv_l, kr_l, st_l = run_trunk(x_prompt, c_ctx, p, None, None)
    new_mla_ckv = jnp.stack(ckv_l, axis=1)
    new_mla_krope = jnp.stack(kr_l, axis=1)
    new_gla_state = jnp.stack(st_l, axis=1).astype(x_prompt.dtype)
    angles = axial_rope_angles(x_sample.shape[1])
    y_sample, _, _, _ = run_trunk(x_sample, c, p, angles, (cache_mla_ckv, cache_mla_krope, state_gla))
    return (y_prompt, y_sample, new_mla_ckv, new_mla_krope, new_gla_state)
```

```cpp
#include <hip/hip_runtime.h>
#include <hip/hip_cooperative_groups.h>
#include <cstdio>
#include <cstdint>
namespace cg = cooperative_groups;

#define LAS __attribute__((address_space(3)))
typedef unsigned short bf16_t;
typedef short bf16x8 __attribute__((ext_vector_type(8)));
typedef short bf16x4 __attribute__((ext_vector_type(4)));
typedef float f32x4 __attribute__((ext_vector_type(4)));
typedef float f32x16 __attribute__((ext_vector_type(16)));
typedef unsigned u32x4 __attribute__((ext_vector_type(4)));
typedef unsigned u32x2 __attribute__((ext_vector_type(2)));

constexpr int D = 1024, TC = 8192, TS = 16384, T = TC + TS, TK = T + 1024;
constexpr int FFN = 2816, PA_LD = 640, PB_LD = 1664;
constexpr int PB_KROPE = 0, PB_GQ = 32, PB_GK = 288, PB_GV = 544, PB_GG = 1056, PB_GA = 1568;
constexpr int LKS = 4352;
constexpr float EPS = 1e-6f;
constexpr float QSCALE = 1.4426950408889634f * 0.10206207261596577f;

constexpr size_t W_WIN = 0;
constexpr size_t W_WUQ = W_WIN + (size_t)2304 * 1024 * 2;
constexpr size_t W_WUKV = W_WUQ + (size_t)768 * 384 * 2;
constexpr size_t W_WOUT = W_WUKV + (size_t)1024 * 256 * 2;
constexpr size_t W_WPW1 = W_WOUT + (size_t)1024 * 1024 * 2;
constexpr size_t W_WPW2 = W_WPW1 + (size_t)2048 * 1024 * 2;
constexpr size_t W_WGU = W_WPW2 + (size_t)1024 * 1024 * 2;
constexpr size_t W_WDN = W_WGU + (size_t)2 * 5632 * 1024 * 2;
constexpr size_t W_MOD = W_WDN + (size_t)2 * 1024 * 2816 * 2;
constexpr size_t W_ROPE = W_MOD + (size_t)5 * 2 * 6 * 1024 * 4;
constexpr size_t W_R1 = W_ROPE + (size_t)4096 * 16 * 8;
constexpr size_t W_R3 = W_R1 + (size_t)T * 1024 * 2;
constexpr size_t W_QRAW = W_R3;
constexpr size_t W_KVRAW = W_R3 + (size_t)T * 768 * 2;
constexpr size_t W_VTC = W_KVRAW + (size_t)TK * 1024 * 2;
constexpr size_t W_VTS = W_VTC + (size_t)32 * 8 * 64 * 256 * 2;
constexpr size_t W_DS = W_VTS + (size_t)4 * 8 * 64 * LKS * 2;
constexpr size_t W_END = W_DS + (size_t)1536 * 2 * 8192 * 2;
static_assert(W_END <= (size_t)256 * 1024 * 1024, "workspace");
static_assert(W_R3 + (size_t)T * FFN * 2 <= (size_t)256 * 1024 * 1024, "workspace (ACT)");
constexpr size_t W_CQN = W_R1;
constexpr size_t W_CKVN = W_R1 + (size_t)T * 384 * 2;
constexpr size_t W_BAR = W_END;
constexpr size_t W_RS = W_BAR + 16384;
constexpr size_t W_GM = W_RS + (size_t)5 * T * 4;
constexpr size_t W_NB = W_GM + (size_t)3 * 5 * 1024 * 4;
constexpr size_t W_AUX_END = W_NB + (size_t)5 * 13312 * 4;
static_assert(W_AUX_END <= (size_t)256 * 1024 * 1024, "aux buffers");
constexpr size_t W_CQ = W_DS, W_CKV = W_DS + (size_t)20 * 1024 * 1024;
constexpr size_t W_XS = W_R1 + (size_t)T * FFN * 2;
static_assert(W_XS + (size_t)T * 1024 * 2 <= W_END, "XS");
constexpr size_t O_CKV = (size_t)T * 1024, O_KROPE = O_CKV + (size_t)8192 * 256, O_STATE = O_KROPE + (size_t)8192 * 32;
constexpr size_t OS_PB = 0, OS_E = (size_t)T * PB_LD * 2;
static_assert(OS_E + (size_t)1536 * 2 * 64 * 4 <= (size_t)T * 1024 * 4, "d_out scratch");

struct Params { const float* in[33]; float* out; unsigned char* ws; };

__device__ __forceinline__ float bf2f(bf16_t v) { return __uint_as_float(((unsigned)v) << 16); }
__device__ __forceinline__ float bflo(unsigned u) { return __uint_as_float(u << 16); }
__device__ __forceinline__ float bfhi(unsigned u) { return __uint_as_float(u & 0xffff0000u); }
typedef __bf16 bf16v2_t __attribute__((ext_vector_type(2)));
typedef float f32x2_t __attribute__((ext_vector_type(2)));
__device__ __forceinline__ unsigned pk2(float lo, float hi) { const f32x2_t v = {lo, hi}; const bf16v2_t b = __builtin_convertvector(v, bf16v2_t); return __builtin_bit_cast(unsigned, b); }
__device__ __forceinline__ bf16_t f2bf(float f) { return (bf16_t)(pk2(f, 0.f) & 0xffffu); }
template <int CTRL> __device__ __forceinline__ float dpp_xadd(float v) { return v + __int_as_float(__builtin_amdgcn_update_dpp(0, __float_as_int(v), CTRL, 0xf, 0xf, true)); }
__device__ __forceinline__ float wave_sum(float v) {
    v = dpp_xadd<0xB1>(v);
    v = dpp_xadd<0x4E>(v);
    v = dpp_xadd<0x141>(v);
    v = dpp_xadd<0x140>(v);
    const int iv = __float_as_int(v);
    return __int_as_float(__builtin_amdgcn_readlane(iv, 0)) + __int_as_float(__builtin_amdgcn_readlane(iv, 16)) + __int_as_float(__builtin_amdgcn_readlane(iv, 32)) + __int_as_float(__builtin_amdgcn_readlane(iv, 48));
}
__device__ __forceinline__ float sigmoidf_(float x) { return __builtin_amdgcn_rcpf(1.f + __expf(-x)); }
__device__ __forceinline__ int tid_opaque() { int t = threadIdx.x; asm volatile("" : "+v"(t)); return t; }
__device__ __forceinline__ int row_group(int r) { return r < TC ? 0 : 1 + ((r - TC) >> 12); }

namespace pg8 {
constexpr int BM = 256, BK = 64, HALF = 128, HTB = HALF * BK * 2, STAGE_BYTES = 8 * HTB, NXCD = 8, WGM = 8;
__host__ __device__ __forceinline__ int lds_byte(int r, int c) { const int st = (r >> 4) * 2 + (c >> 5), rr = r & 15, cc = c & 31, ob = rr * 64 + cc * 2; return st * 1024 + (ob ^ (((ob >> 9) & 1) << 5)); }
__host__ __device__ __forceinline__ void stage_rc(int b, int& R, int& C) { const int st = b / 1024, sb = b % 1024, swz = sb ^ (((sb >> 9) & 1) << 5); R = (st >> 1) * 16 + swz / 64; C = (st & 1) * 32 + (swz % 64) / 2; }
__host__ __device__ __forceinline__ int perm32(int rho) { const int n = rho >> 4, i = rho & 15; return 8 * (i >> 2) + 4 * n + (i & 3); }
struct Unit { int pm, pn, half; };
struct Gemm { const bf16_t* A; const bf16_t* Bt; int M, N, K; };
struct StaticOrder {
    int nM, nN, nwg, G, c;
    int nFull;
    __device__ void init(int M, int N, int G_, int c_) { nM = M / BM; nN = N / BM; nwg = nM * nN; G = G_; c = c_; nFull = (nwg / G) * G; if (2 * (nwg - nFull) > G) nFull = nwg; }
    __device__ bool next(int i, Unit& u) const {
        const long L = (long)i * G + c; if (L >= nFull + 2 * (nwg - nFull)) return false;
        int wgid = (int)L; u.half = 0;
        if (wgid >= nFull) { const int hs = wgid - nFull; u.half = 1 + (hs & 1); wgid = nFull + (hs >> 1); } { const int q = nwg / NXCD, r = nwg % NXCD, xcd = wgid % NXCD, off = wgid / NXCD; wgid = (xcd < r ? xcd * (q + 1) : r * (q + 1) + (xcd - r) * q) + off; }
        const int nig = WGM * nN, gid = wgid / nig, fm = gid * WGM, gsz = (nM - fm) < WGM ? (nM - fm) : WGM;
        u.pm = fm + ((wgid % nig) % gsz); u.pn = (wgid % nig) / gsz; return true;
    }
};

template <class Epi>
__device__ __forceinline__ void gemm_phase(LAS unsigned char* lds, const Gemm g, const StaticOrder& S, const Epi& E) {
    const int tid = tid_opaque(), wid = __builtin_amdgcn_readfirstlane(tid >> 6), lane = tid & 63, wr = wid >> 2, wc = wid & 3, fr = lane & 15, fq = lane >> 4;
    const int K = g.K, nt = K / BK;
    unsigned voffA[2], voffB[2];
#pragma unroll
    for (int i = 0; i < 2; ++i) { int R, C; stage_rc(tid * 16 + i * 8192, R, C); const int Rb = Epi::PERM ? ((R & ~31) + perm32(R & 31)) : R;
        voffA[i] = (unsigned)(R * K + C) * 2u; voffB[i] = (unsigned)(Rb * K + C) * 2u; }
    const size_t kstep = (size_t)(BK * 2);
    const size_t hstep = (size_t)HALF * K * 2;
    const size_t tstep = 2 * hstep;
    const unsigned ldsw = (unsigned)wid * 1024u;
    const int aoff = lds_byte(wr * 64 + fr, fq * 8), boff = lds_byte(wc * 32 + fr, fq * 8);
#define PG8_SA(b, h) (((b) * 2 + (h)) * HTB)
#define PG8_SB(b, h) ((4 + (b) * 2 + (h)) * HTB)
#define PG8_STAGE(bufoff, gbase, voff) do { _Pragma("unroll") for (int _i = 0; _i < 2; ++_i) \
        __builtin_amdgcn_global_load_lds((const unsigned*)((const char*)(gbase) + (voff)[_i]), (LAS unsigned*)(lds + (bufoff) + ldsw + _i * 8192), 16, 0, 0); } while (0)
#define PG8_LDA(dst, b, h) do { _Pragma("unroll") for (int m = 0; m < 4; ++m) _Pragma("unroll") for (int k = 0; k < 2; ++k) dst[m][k] = *(const LAS bf16x8*)(lds + PG8_SA(b, h) + aoff + m * 2048 + k * 1024); } while (0)
#define PG8_LDB(dst, b, h) do { _Pragma("unroll") for (int n = 0; n < 2; ++n) _Pragma("unroll") for (int k = 0; k < 2; ++k) dst[n][k] = *(const LAS bf16x8*)(lds + PG8_SB(b, h) + boff + n * 2048 + k * 1024); } while (0)
#define PG8_MMA(ai, bj, At, Bt) do { __builtin_amdgcn_s_setprio(1); _Pragma("unroll") for (int m = 0; m < 4; ++m) _Pragma("unroll") for (int n = 0; n < 2; ++n) _Pragma("unroll") for (int k = 0; k < 2; ++k) \
        acc[ai][bj][m][n] = __builtin_amdgcn_mfma_f32_16x16x32_bf16(Bt[n][k], At[m][k], acc[ai][bj][m][n], 0, 0, 0); __builtin_amdgcn_s_setprio(0); } while (0)
#define PG8_WAIT_V(n) asm volatile("s_waitcnt vmcnt(" #n ")" ::: "memory")
#define PG8_WAIT_L(n) asm volatile("s_waitcnt lgkmcnt(" #n ")" ::: "memory")
#define PG8_BAR __builtin_amdgcn_s_barrier()
#define PG8_SCHED __builtin_amdgcn_sched_barrier(0)
    Unit cur, nxt; int ui = 0;
    if (!S.next(0, cur)) return;
    f32x4 acc[2][2][4][2];
#pragma unroll
    for (int a = 0; a < 2; ++a)
#pragma unroll
        for (int b = 0; b < 2; ++b)
#pragma unroll
            for (int m = 0; m < 4; ++m)
#pragma unroll
                for (int n = 0; n < 2; ++n) acc[a][b][m][n] = (f32x4){0.f, 0.f, 0.f, 0.f};
    bf16x8 At[4][2], B0[2][2], B1[2][2];
    const char* cA = (const char*)g.A + (size_t)cur.pm * tstep + (cur.half == 2 ? hstep : (size_t)0); const char* cB = (const char*)g.Bt + (size_t)cur.pn * tstep;
    PG8_STAGE(PG8_SB(0, 0), cB, voffB); PG8_STAGE(PG8_SA(0, 0), cA, voffA); PG8_STAGE(PG8_SB(0, 1), cB + hstep, voffB); PG8_STAGE(PG8_SA(0, 1), cA + hstep, voffA);
    if (wr == 1) PG8_BAR;
    PG8_WAIT_V(4); PG8_BAR;
    PG8_STAGE(PG8_SB(1, 0), cB + kstep, voffB); PG8_STAGE(PG8_SA(1, 0), cA + kstep, voffA); PG8_STAGE(PG8_SB(1, 1), cB + hstep + kstep, voffB);
    PG8_WAIT_V(6); PG8_BAR;
    for (;;) {
        const bool has_next = S.next(ui + 1, nxt);
        const char* nA = has_next ? (const char*)g.A + (size_t)nxt.pm * tstep + (nxt.half == 2 ? hstep : (size_t)0) : cA; const bool whole = (cur.half == 0); const char* nB = has_next ? (const char*)g.Bt + (size_t)nxt.pn * tstep : cB;
        for (int t = 0; t < nt; t += 2) {
            const bool last = (t == nt - 2);
            const char* a1 = cA + (size_t)(t + 1) * kstep;
            const char* a2 = last ? nA : cA + (size_t)(t + 2) * kstep; const char* b2 = last ? nB : cB + (size_t)(t + 2) * kstep;
            const char* a3 = a2 + kstep; const char* b3 = b2 + kstep;
            PG8_LDB(B0, 0, 0); PG8_SCHED; PG8_LDA(At, 0, 0); PG8_STAGE(PG8_SA(1, 1), a1 + hstep, voffA);
            PG8_WAIT_L(8); PG8_BAR; PG8_WAIT_L(0); PG8_MMA(0, 0, At, B0); PG8_BAR; PG8_SCHED;
            PG8_LDB(B1, 0, 1); PG8_STAGE(PG8_SB(0, 0), b2, voffB);
            PG8_BAR; PG8_WAIT_L(0); PG8_MMA(0, 1, At, B1); PG8_BAR;
            if (whole) PG8_LDA(At, 0, 1); PG8_STAGE(PG8_SA(0, 0), a2, voffA);
            PG8_BAR; PG8_WAIT_L(0); if (whole) PG8_MMA(1, 0, At, B0); PG8_BAR; PG8_SCHED;
            PG8_STAGE(PG8_SB(0, 1), b2 + hstep, voffB);
            PG8_WAIT_V(6); PG8_BAR; if (whole) PG8_MMA(1, 1, At, B1); PG8_BAR;
            PG8_LDB(B0, 1, 0); PG8_SCHED; PG8_LDA(At, 1, 0); PG8_STAGE(PG8_SA(0, 1), a2 + hstep, voffA);
            PG8_WAIT_L(8); PG8_BAR; PG8_WAIT_L(0); PG8_MMA(0, 0, At, B0); PG8_BAR; PG8_SCHED;
            PG8_LDB(B1, 1, 1); PG8_STAGE(PG8_SB(1, 0), b3, voffB);
            PG8_BAR; PG8_WAIT_L(0); PG8_MMA(0, 1, At, B1); PG8_BAR;
            if (whole) PG8_LDA(At, 1, 1); PG8_STAGE(PG8_SA(1, 0), a3, voffA);
            PG8_BAR; PG8_WAIT_L(0); if (whole) PG8_MMA(1, 0, At, B0); PG8_BAR; PG8_SCHED;
            PG8_STAGE(PG8_SB(1, 1), b3 + hstep, voffB);
            PG8_WAIT_V(6); PG8_BAR; if (whole) PG8_MMA(1, 1, At, B1); PG8_BAR;
        }
        E(acc, cur, wr, wc, fr, fq);
        if (!has_next) break;
#pragma unroll
        for (int a = 0; a < 2; ++a)
#pragma unroll
            for (int b = 0; b < 2; ++b)
#pragma unroll
                for (int m = 0; m < 4; ++m)
#pragma unroll
                    for (int n = 0; n < 2; ++n) acc[a][b][m][n] = (f32x4){0.f, 0.f, 0.f, 0.f};
        cur = nxt; cA = nA; cB = nB; ++ui;
    }
    PG8_WAIT_V(0);
    if (wr == 0) PG8_BAR;
    PG8_BAR;
#undef PG8_SA
#undef PG8_SB
#undef PG8_STAGE
#undef PG8_LDA
#undef PG8_LDB
#undef PG8_MMA
#undef PG8_WAIT_V
#undef PG8_WAIT_L
#undef PG8_BAR
#undef PG8_SCHED
}

typedef const f32x4 (&AccRef)[2][2][4][2];

struct EpiBf16Split {
    static constexpr bool PERM = true;
    bf16_t* O0; int ld0; bf16_t* O1; int ld1; int split;
    __device__ __forceinline__ void operator()(AccRef acc, const Unit& u, int wr, int wc, int fr, int fq) const {
        const int row0 = u.pm * BM + wr * 64 + fr + (u.half == 2 ? HALF : 0); const int nai = u.half ? 1 : 2;
#pragma unroll
        for (int bj = 0; bj < 2; ++bj) {
            const int cb = u.pn * BM + bj * HALF; bf16_t* base; int ld, c;
            if (cb < split) { base = O0; ld = ld0; c = cb; } else { base = O1; ld = ld1; c = cb - split; }
            c += wc * 32 + 8 * fq;
#pragma unroll
            for (int ai = 0; ai < 2; ++ai) if (ai < nai)
#pragma unroll
                for (int m = 0; m < 4; ++m) {
                    const f32x4 v0 = acc[ai][bj][m][0], v1 = acc[ai][bj][m][1];
                    u32x4 o = {pk2(v0[0], v0[1]), pk2(v0[2], v0[3]), pk2(v1[0], v1[1]), pk2(v1[2], v1[3])};
                    *(u32x4*)(base + (size_t)(row0 + ai * HALF + m * 16) * ld + c) = o;
                    __builtin_amdgcn_sched_barrier(0);
                }
        }
    }
};
struct EpiProj {
    static constexpr bool PERM = true;
    bf16_t* CQ; bf16_t* CKV; bf16_t* O1; int ld1; float* rsq; float* rskv;
    __device__ __forceinline__ void operator()(AccRef acc, const Unit& u, int wr, int wc, int fr, int fq) const {
        const int row0 = u.pm * BM + wr * 64 + fr + (u.half == 2 ? HALF : 0); const int nai = u.half ? 1 : 2;
#pragma unroll
        for (int bj = 0; bj < 2; ++bj) {
            const int cb = u.pn * BM + bj * HALF; bf16_t* base; int ld, c; float* rs;
            if (cb < 384) { base = CQ; ld = 384; c = cb; rs = rsq; } else if (cb < 640) { base = CKV; ld = 256; c = cb - 384; rs = rskv; } else { base = O1; ld = ld1; c = cb - 640; rs = nullptr; }
            c += wc * 32 + 8 * fq;
#pragma unroll
            for (int ai = 0; ai < 2; ++ai) if (ai < nai)
#pragma unroll
                for (int m = 0; m < 4; ++m) {
                    const f32x4 v0 = acc[ai][bj][m][0], v1 = acc[ai][bj][m][1];
                    u32x4 o = {pk2(v0[0], v0[1]), pk2(v0[2], v0[3]), pk2(v1[0], v1[1]), pk2(v1[2], v1[3])};
                    *(u32x4*)(base + (size_t)(row0 + ai * HALF + m * 16) * ld + c) = o;
                    if (rs) { float q = v0[0] * v0[0] + v0[1] * v0[1] + v0[2] * v0[2] + v0[3] * v0[3] + v1[0] * v1[0] + v1[1] * v1[1] + v1[2] * v1[2] + v1[3] * v1[3];
                        q += __shfl_xor(q, 16); q += __shfl_xor(q, 32);
                        if (fq == 0) (void)__hip_atomic_fetch_add(rs + row0 + ai * HALF + m * 16, q, __ATOMIC_RELAXED, __HIP_MEMORY_SCOPE_AGENT); }
                    __builtin_amdgcn_sched_barrier(0);
                }
        }
    }
};
struct EpiBf16Scaled {
    static constexpr bool PERM = true;
    bf16_t* O; int ld; const float* rowss; float inv_k; int nscaled;
    __device__ __forceinline__ void operator()(AccRef acc, const Unit& u, int wr, int wc, int fr, int fq) const {
        const int row0 = u.pm * BM + wr * 64 + fr + (u.half == 2 ? HALF : 0); const int nai = u.half ? 1 : 2;
        float rs[2][4];
#pragma unroll
        for (int ai = 0; ai < 2; ++ai)
#pragma unroll
            for (int m = 0; m < 4; ++m) { const int r = row0 + (ai < nai ? ai : 0) * HALF + m * 16; rs[ai][m] = (r < nscaled) ? rowss[r] : -1.f; }
#pragma unroll
        for (int ai = 0; ai < 2; ++ai) if (ai < nai)
#pragma unroll
            for (int m = 0; m < 4; ++m) { const float rinv = rs[ai][m] >= 0.f ? rsqrtf(rs[ai][m] * inv_k + EPS) : 1.f;
#pragma unroll
                for (int bj = 0; bj < 2; ++bj) {
                    const f32x4 v0 = acc[ai][bj][m][0] * rinv, v1 = acc[ai][bj][m][1] * rinv;
                    u32x4 o = {pk2(v0[0], v0[1]), pk2(v0[2], v0[3]), pk2(v1[0], v1[1]), pk2(v1[2], v1[3])};
                    *(u32x4*)(O + (size_t)(row0 + ai * HALF + m * 16) * ld + u.pn * BM + bj * HALF + wc * 32 + 8 * fq) = o; }
                __builtin_amdgcn_sched_barrier(0); }
    }
};
struct EpiResGate {
    static constexpr bool PERM = false;
    float* out; const float* resA; const float* resB; const float* mod; int gate_idx; const float* bias;
    bf16_t* xs; const float* gm; float* rowss;
    __device__ __forceinline__ void operator()(AccRef acc, const Unit& u, int wr, int wc, int fr, int fq) const {
        const int row0 = u.pm * BM + wr * 64 + fr + (u.half == 2 ? HALF : 0), col0 = u.pn * BM + wc * 32 + 4 * fq; const int nai = u.half ? 1 : 2;
        const int g = row_group(u.pm * BM);
        const float* res = (u.pm * BM < TC) ? resA : resB;
        const float* gp = mod + (size_t)(g * 12 + gate_idx) * 1024;
        f32x4 gv[2][2], gmv[2][2], bv[2][2];
#pragma unroll
        for (int bj = 0; bj < 2; ++bj)
#pragma unroll
            for (int n = 0; n < 2; ++n) { const int cc = col0 + bj * HALF + n * 16;
                gv[bj][n] = *(const f32x4*)(gp + cc);
                gmv[bj][n] = xs ? *(const f32x4*)(gm + (size_t)g * 1024 + cc) : (f32x4){0.f, 0.f, 0.f, 0.f};
                bv[bj][n] = bias ? *(const f32x4*)(bias + cc) : (f32x4){0.f, 0.f, 0.f, 0.f}; }
        const int nrow = nai * 4;
        f32x4 rcur[2][2], rnxt[2][2];
#pragma unroll
        for (int bj = 0; bj < 2; ++bj)
#pragma unroll
            for (int n = 0; n < 2; ++n) rcur[bj][n] = *(const f32x4*)(res + (size_t)row0 * 1024 + col0 + bj * HALF + n * 16);
#pragma unroll
        for (int it = 0; it < 8; ++it) if (it < nrow) {
            const int ai = it >> 2, m = it & 3;
            const size_t ro = (size_t)(row0 + ai * HALF + m * 16) * 1024 + col0; float ssq = 0.f;
            if (it + 1 < nrow) { const size_t rn = (size_t)(row0 + ((it + 1) >> 2) * HALF + ((it + 1) & 3) * 16) * 1024 + col0;
#pragma unroll
                for (int bj = 0; bj < 2; ++bj)
#pragma unroll
                    for (int n = 0; n < 2; ++n) rnxt[bj][n] = *(const f32x4*)(res + rn + bj * HALF + n * 16); }
#pragma unroll
            for (int bj = 0; bj < 2; ++bj)
#pragma unroll
                for (int n = 0; n < 2; ++n) {
                    const f32x4 o = rcur[bj][n] + gv[bj][n] * (acc[ai][bj][m][n] + bv[bj][n]);
                    *(f32x4*)(out + ro + bj * HALF + n * 16) = o;
                    if (xs) { const f32x4 y = o * gmv[bj][n];
                        *(u32x2*)(xs + ro + bj * HALF + n * 16) = (u32x2){pk2(y[0], y[1]), pk2(y[2], y[3])};
                        ssq += o[0] * o[0] + o[1] * o[1] + o[2] * o[2] + o[3] * o[3]; } }
            if (xs) { ssq += __shfl_xor(ssq, 16); ssq += __shfl_xor(ssq, 32);
                if (fq == 0) (void)__hip_atomic_fetch_add(rowss + row0 + ai * HALF + m * 16, ssq, __ATOMIC_RELAXED, __HIP_MEMORY_SCOPE_AGENT); }
#pragma unroll
            for (int bj = 0; bj < 2; ++bj)
#pragma unroll
                for (int n = 0; n < 2; ++n) rcur[bj][n] = rnxt[bj][n];
            __builtin_amdgcn_sched_barrier(0); }
    }
};
template <int MODE> struct EpiGated {
    static constexpr bool PERM = true;
    bf16_t* O; int ldo; const float* nb; const float* rowss;
    __device__ __forceinline__ void operator()(AccRef acc, const Unit& u, int wr, int wc, int fr, int fq) const {
        const int row0 = u.pm * BM + wr * 64 + fr + (u.half == 2 ? HALF : 0), c = u.pn * HALF + wc * 32 + 8 * fq; const int nai = u.half ? 1 : 2;
        const float* nbp = nb + (size_t)row_group(u.pm * BM) * 13312 + u.pn * 256 + wc * 32 + 8 * fq;
        f32x4 ba[2], bb[2];
#pragma unroll
        for (int n = 0; n < 2; ++n) { ba[n] = *(const f32x4*)(nbp + 4 * n); bb[n] = *(const f32x4*)(nbp + 128 + 4 * n); }
        float rs[2][4];
#pragma unroll
        for (int ai = 0; ai < 2; ++ai)
#pragma unroll
            for (int m = 0; m < 4; ++m) rs[ai][m] = rowss[row0 + (ai < nai ? ai : 0) * HALF + m * 16];
#pragma unroll
        for (int ai = 0; ai < 2; ++ai) if (ai < nai)
#pragma unroll
            for (int m = 0; m < 4; ++m) {
                float r[8];
                const float rinv = rsqrtf(rs[ai][m] * (1.f / 1024.f) + EPS);
#pragma unroll
                for (int n = 0; n < 2; ++n)
#pragma unroll
                    for (int e = 0; e < 4; ++e) { const float a = acc[ai][0][m][n][e] * rinv + ba[n][e], b = acc[ai][1][m][n][e] * rinv + bb[n][e];
                        r[n * 4 + e] = (MODE == 0) ? a * sigmoidf_(a) * b : a * sigmoidf_(b); }
                u32x4 o = {pk2(r[0], r[1]), pk2(r[2], r[3]), pk2(r[4], r[5]), pk2(r[6], r[7])};
                *(u32x4*)(O + (size_t)(row0 + ai * HALF + m * 16) * ldo + c) = o;
                if (m & 1) __builtin_amdgcn_sched_barrier(0);
            }
    }
};
}

__device__ __forceinline__ void conv_tile(const float* __restrict__ W, int K, int N, bf16_t* __restrict__ Wt, int kt, int ntile, int map, int half_n, float* sm) {
    const int t = tid_opaque(), k0 = kt * 64, n0 = ntile * 64;
#pragma unroll
    for (int i = 0; i < 8; ++i) { const int idx = i * 512 + t, kk = idx >> 6, nn = idx & 63; sm[kk * 65 + nn] = W[(size_t)(k0 + kk) * N + n0 + nn]; }
    __syncthreads();
    const int nn = t >> 3, ks = (t & 7) * 8;
    float v[8];
#pragma unroll
    for (int j = 0; j < 8; ++j) v[j] = sm[(ks + j) * 65 + nn];
    int n = n0 + nn, dst;
    if (map == 0) dst = n;
    else { int up = 0; if (n >= half_n) { n -= half_n; up = 128; } dst = (n >> 7) * 256 + (n & 127) + up; }
    u32x4 o = {pk2(v[0], v[1]), pk2(v[2], v[3]), pk2(v[4], v[5]), pk2(v[6], v[7])};
    *(u32x4*)(Wt + (size_t)dst * K + k0 + ks) = o;
    __syncthreads();
}

__device__ __forceinline__ void p0_prologue(const Params& P, unsigned char* smraw) {
    float* sm = (float*)smraw;
    unsigned char* ws = P.ws;
    const int t = tid_opaque();
    constexpr int N_ADA = 256, N_ZERO = 1, N_ROPE = 16, N_CONV = 0;
    constexpr int I_ZERO = N_ADA, I_ROPE = I_ZERO + N_ZERO, I_CONV = I_ROPE + N_ROPE, N_ITEMS = I_CONV + N_CONV;
    for (int it = blockIdx.x; it < N_ITEMS; it += gridDim.x) {
        if (it < N_ADA) {
            const int layer = it >> 7, cch = it & 127;
            float* sc = sm;
            float* red = sm + 5 * 1024;
            for (int i = t; i < 5 * 1024; i += 512) { const int g = i >> 10, k = i & 1023; const float c = (g == 0) ? P.in[6][k] : P.in[5][(g - 1) * 1024 + k]; sc[i] = c * sigmoidf_(c); }
            __syncthreads();
            if (t < 384) {
                const int cg4 = t % 12, kg = t / 12;
                const float* w = P.in[7] + (size_t)layer * 1024 * 6144 + (size_t)(kg * 32) * 6144 + cch * 48 + cg4 * 4;
                f32x4 a[5];
#pragma unroll
                for (int g = 0; g < 5; ++g) a[g] = (f32x4){0.f, 0.f, 0.f, 0.f};
#pragma unroll 16
                for (int kk = 0; kk < 32; ++kk) { const f32x4 w4 = *(const f32x4*)(w + (size_t)kk * 6144);
#pragma unroll
                    for (int g = 0; g < 5; ++g) a[g] += w4 * sc[g * 1024 + kg * 32 + kk]; }
#pragma unroll
                for (int g = 0; g < 5; ++g) *(f32x4*)(red + (kg * 5 + g) * 48 + cg4 * 4) = a[g];
            }
            __syncthreads();
            if (t < 240) { const int g = t / 48, c = t % 48; float s_ = 0.f;
#pragma unroll 8
                for (int k2 = 0; k2 < 32; ++k2) s_ += red[(k2 * 5 + g) * 48 + c];
                const int col = cch * 48 + c;
                ((float*)(ws + W_MOD))[(size_t)(g * 2 + layer) * 6144 + col] = s_ + P.in[8][layer * 6144 + col]; }
            __syncthreads();
        } else if (it < I_ROPE) {
            u32x4* z = (u32x4*)(ws + W_WIN + (size_t)2240 * 1024 * 2);
            for (int i = t; i < 64 * 1024 * 2 / 16; i += 512) z[i] = (u32x4){0u, 0u, 0u, 0u};
        } else if (it < I_CONV) {
            const int base = (it - I_ROPE) * 4096;
            float2* rp = (float2*)(ws + W_ROPE);
            for (int i = t; i < 4096; i += 512) { const int e = base + i, l = e >> 4, f = e & 15, ax = f >> 3, fi = f & 7;
                const float pos = (float)(ax == 0 ? (l >> 6) : (l & 63));
                const float invf = powf(10000.f, -(float)(2 * fi) / 16.f);
                float s, c; sincosf(pos * invf, &s, &c); rp[e] = make_float2(c, s); }
        }
    }
    struct Job { const float* W; bf16_t* Wt; const float* ksc; int K, N, map, half, k0, n0; };
#define P0_DECODE(tile_, J) do { int tl = (tile_); (J).map = 0; (J).half = 1 << 30; (J).ksc = nullptr; \
        if (tl < 560) { (J).W = P.in[11]; (J).K = 1024; (J).N = 2240; (J).Wt = (bf16_t*)(ws + W_WIN); } \
        else if ((tl -= 560) < 72) { (J).W = P.in[13]; (J).K = 384; (J).N = 768; (J).Wt = (bf16_t*)(ws + W_WUQ); (J).ksc = P.in[12]; } \
        else if ((tl -= 72) < 64) { (J).W = P.in[15]; (J).K = 256; (J).N = 1024; (J).Wt = (bf16_t*)(ws + W_WUKV); (J).ksc = P.in[14]; } \
        else if ((tl -= 64) < 256) { (J).W = P.in[21]; (J).K = 1024; (J).N = 1024; (J).Wt = (bf16_t*)(ws + W_WOUT); } \
        else if ((tl -= 256) < 512) { (J).W = P.in[22]; (J).K = 1024; (J).N = 2048; (J).Wt = (bf16_t*)(ws + W_WPW1); (J).map = 1; (J).half = 1024; } \
        else if ((tl -= 512) < 256) { (J).W = P.in[28]; (J).K = 1024; (J).N = 1024; (J).Wt = (bf16_t*)(ws + W_WPW2); } \
        else if ((tl -= 256) < 1408) { const int l = tl / 704; tl -= l * 704; (J).W = P.in[30] + (size_t)l * 1024 * FFN; (J).K = 1024; (J).N = FFN; (J).Wt = (bf16_t*)(ws + W_WGU) + (size_t)l * 5632 * 1024; (J).map = 1; } \
        else if ((tl -= 1408) < 1408) { const int l = tl / 704; tl -= l * 704; (J).W = P.in[31] + (size_t)l * 1024 * FFN; (J).K = 1024; (J).N = FFN; (J).Wt = (bf16_t*)(ws + W_WGU) + (size_t)l * 5632 * 1024 + (size_t)128 * 1024; (J).map = 1; } \
        else { tl -= 1408; const int l = tl / 704; tl -= l * 704; (J).W = P.in[32] + (size_t)l * FFN * 1024; (J).K = FFN; (J).N = 1024; (J).Wt = (bf16_t*)(ws + W_WDN) + (size_t)l * 1024 * FFN; } \
        const int nN_ = (J).N / 64; (J).k0 = (tl / nN_) * 64; (J).n0 = (tl % nN_) * 64; } while (0)
#define P0_LOAD(J, v) do { _Pragma("unroll") for (int i_ = 0; i_ < 8; ++i_) { const int idx_ = i_ * 512 + t; v[i_] = (J).W[(size_t)((J).k0 + (idx_ >> 6)) * (J).N + (J).n0 + (idx_ & 63)]; } } while (0)
    {
        Job J, Jn; float v[8];
        int tile = blockIdx.x;
        if (tile < 5944) { P0_DECODE(tile, J); P0_LOAD(J, v); }
        for (; tile < 5944; tile += gridDim.x) {
#pragma unroll
            for (int i = 0; i < 8; ++i) { const int idx = i * 512 + t; sm[(idx >> 6) * 65 + (idx & 63)] = J.ksc ? v[i] * J.ksc[J.k0 + (idx >> 6)] : v[i]; }
            __syncthreads();
            const int nt_ = tile + (int)gridDim.x;
            if (nt_ < 5944) { P0_DECODE(nt_, Jn); P0_LOAD(Jn, v); }
            const int nn = t >> 3, ks = (t & 7) * 8;
            float x[8];
#pragma unroll
            for (int j = 0; j < 8; ++j) x[j] = sm[(ks + j) * 65 + nn];
            int n = J.n0 + nn, dst;
            if (J.map == 0) dst = n;
            else { int up = 0; if (n >= J.half) { n -= J.half; up = 128; } dst = (n >> 7) * 256 + (n & 127) + up; }
            *(u32x4*)(J.Wt + (size_t)dst * J.K + J.k0 + ks) = (u32x4){pk2(x[0], x[1]), pk2(x[2], x[3]), pk2(x[4], x[5]), pk2(x[6], x[7])};
            __syncthreads();
            J = Jn;
        }
    }
#undef P0_DECODE
#undef P0_LOAD
}

__device__ __forceinline__ void norm_phase(const float* xa, const float* xb, const float* gain, const float* mod, int mod_idx, bf16_t* H) {
    const int t_ = tid_opaque(), wave = t_ >> 6, lane = t_ & 63;
    for (int r = blockIdx.x * 8 + wave; r < T; r += gridDim.x * 8) {
        const float* x = (r < TC ? xa : xb) + (size_t)r * 1024;
        const float* sh = mod + (size_t)(row_group(r) * 12 + mod_idx) * 1024; const float* sc = sh + 1024;
        f32x4 v[4]; float ss = 0.f;
#pragma unroll
        for (int i = 0; i < 4; ++i) { v[i] = ((const f32x4*)x)[lane + 64 * i]; ss += v[i][0] * v[i][0] + v[i][1] * v[i][1] + v[i][2] * v[i][2] + v[i][3] * v[i][3]; }
        ss = wave_sum(ss);
        const float rinv = rsqrtf(ss * (1.f / 1024.f) + EPS);
#pragma unroll
        for (int i = 0; i < 4; ++i) { const int c = 4 * (lane + 64 * i);
            const f32x4 g4 = *(const f32x4*)(gain + c), s4 = *(const f32x4*)(sc + c), h4 = *(const f32x4*)(sh + c);
            const f32x4 y = v[i] * rinv * g4 * (s4 + 1.f) + h4;
            *(u32x2*)(H + (size_t)r * 1024 + c) = (u32x2){pk2(y[0], y[1]), pk2(y[2], y[3])}; }
    }
}

__device__ __forceinline__ void p1_aux(const Params& P) {
    unsigned char* ws = P.ws;
    const float* MOD = (const float*)(ws + W_MOD);
    const int t = tid_opaque(), wave = t >> 6, lane = t & 63;
    float* RS = (float*)(ws + W_RS);
    for (int i = blockIdx.x * 512 + t; i < 5 * T; i += gridDim.x * 512) RS[i] = 0.f;
    { bf16_t* CKV = (bf16_t*)(ws + W_CKV) + (size_t)T * 256;
      for (int i = blockIdx.x * 512 + t; i < 1024 * 256 / 4; i += gridDim.x * 512) { const f32x4 v = ((const f32x4*)P.in[2])[i], k4 = *(const f32x4*)(P.in[14] + ((i * 4) & 255));
          *(u32x2*)(CKV + (size_t)i * 4) = (u32x2){pk2(v[0] / k4[0], v[1] / k4[1]), pk2(v[2] / k4[2], v[3] / k4[3])}; } }
    float* GM = (float*)(ws + W_GM);
    for (int i = blockIdx.x * 512 + t; i < 3 * 5 * 1024; i += gridDim.x * 512) { const int j = i / 5120, g = (i % 5120) >> 10, c = i & 1023;
        const float gain = (j == 0) ? P.in[10][c] : (j == 1) ? P.in[9][1024 + c] : P.in[10][1024 + c];
        const int sci = (j == 0) ? 4 : (j == 1) ? 7 : 10;
        GM[i] = gain * (1.f + MOD[(size_t)(g * 12 + sci) * 1024 + c]); }
    float* NB = (float*)(ws + W_NB);
    for (int row = blockIdx.x * 8 + wave; row < 13312; row += gridDim.x * 8) {
        const bf16_t* wt; int shi; float extra = 0.f;
        if (row < 5632) { wt = (const bf16_t*)(ws + W_WGU) + (size_t)row * 1024; shi = 3; }
        else if (row < 7680) { const int n = row - 5632, w = n & 255; wt = (const bf16_t*)(ws + W_WPW1) + (size_t)n * 1024; shi = 6; extra = P.in[23][(n >> 8) * 128 + (w & 127) + (w >= 128 ? 1024 : 0)]; }
        else { wt = (const bf16_t*)(ws + W_WGU) + (size_t)5632 * 1024 + (size_t)(row - 7680) * 1024; shi = 9; }
        const u32x4 w0 = *(const u32x4*)(wt + lane * 16), w1 = *(const u32x4*)(wt + lane * 16 + 8);
        float wf[16];
#pragma unroll
        for (int e = 0; e < 4; ++e) { wf[2 * e] = bflo(w0[e]); wf[2 * e + 1] = bfhi(w0[e]); wf[8 + 2 * e] = bflo(w1[e]); wf[8 + 2 * e + 1] = bfhi(w1[e]); }
#pragma unroll
        for (int g = 0; g < 5; ++g) { const float* sh = MOD + (size_t)(g * 12 + shi) * 1024 + lane * 16; float a = 0.f;
#pragma unroll
            for (int q = 0; q < 4; ++q) { const f32x4 v = *(const f32x4*)(sh + 4 * q); a += v[0] * wf[4 * q] + v[1] * wf[4 * q + 1] + v[2] * wf[4 * q + 2] + v[3] * wf[4 * q + 3]; }
            a = wave_sum(a);
            if (lane == 0) NB[(size_t)g * 13312 + row] = a + extra; }
    }
}

__device__ __forceinline__ void p3_postproj(const Params& P) {
    unsigned char* ws = P.ws;
    const bf16_t* PA = (const bf16_t*)(ws + W_R3); const bf16_t* PB = (const bf16_t*)((unsigned char*)P.out + OS_PB);
    bf16_t* CQN = (bf16_t*)(ws + W_CQN); bf16_t* CKVN = (bf16_t*)(ws + W_CKVN);
    const float* qa = P.in[12]; const float* kva = P.in[14];
    const int t_ = tid_opaque(), wave = t_ >> 6, lane = t_ & 63;
    constexpr int RW = 4;
    float qg[6]; { for (int i = 0; i < 3; ++i) { qg[2 * i] = qa[2 * lane + 128 * i]; qg[2 * i + 1] = qa[2 * lane + 128 * i + 1]; } }
    const f32x4 g4 = *(const f32x4*)(kva + 4 * lane);
    for (int r0 = (blockIdx.x * 8 + wave) * RW; r0 < T; r0 += gridDim.x * 8 * RW) {
        unsigned q[RW][3]; u32x2 kv[RW]; unsigned short kr[RW];
#pragma unroll
        for (int j = 0; j < RW; ++j) { const bf16_t* pa = PA + (size_t)(r0 + j) * PA_LD;
#pragma unroll
            for (int i = 0; i < 3; ++i) q[j][i] = *(const unsigned*)(pa + 2 * lane + 128 * i);
            kv[j] = *(const u32x2*)(pa + 384 + 4 * lane);
            kr[j] = (r0 < TC && lane < 32) ? PB[(size_t)(r0 + j) * PB_LD + PB_KROPE + lane] : (unsigned short)0; }
#pragma unroll
        for (int j = 0; j < RW; ++j) { const int r = r0 + j;
            float ss = 0.f;
#pragma unroll
            for (int i = 0; i < 3; ++i) { const float a = bflo(q[j][i]), b = bfhi(q[j][i]); ss += a * a + b * b; }
            const float k0 = bflo(kv[j][0]), k1 = bfhi(kv[j][0]), k2 = bflo(kv[j][1]), k3 = bfhi(kv[j][1]);
            float s2 = k0 * k0 + k1 * k1 + k2 * k2 + k3 * k3;
#pragma unroll
            for (int m = 32; m >= 1; m >>= 1) { ss += __shfl_xor(ss, m); s2 += __shfl_xor(s2, m); }
            const float rinv = rsqrtf(ss * (1.f / 384.f) + EPS), rinv2 = rsqrtf(s2 * (1.f / 256.f) + EPS);
#pragma unroll
            for (int i = 0; i < 3; ++i) *(unsigned*)(CQN + (size_t)r * 384 + 2 * lane + 128 * i) = pk2(bflo(q[j][i]) * rinv * qg[2 * i], bfhi(q[j][i]) * rinv * qg[2 * i + 1]);
            const f32x4 y = {k0 * rinv2 * g4[0], k1 * rinv2 * g4[1], k2 * rinv2 * g4[2], k3 * rinv2 * g4[3]};
            *(u32x2*)(CKVN + (size_t)r * 256 + 4 * lane) = (u32x2){pk2(y[0], y[1]), pk2(y[2], y[3])};
            if (r < TC) {
                *(f32x4*)(P.out + O_CKV + (size_t)r * 256 + 4 * lane) = y;
                if (lane < 32) P.out[O_KROPE + (size_t)r * 32 + lane] = bf2f(kr[j]);
            } }
    }
    for (int r = T + blockIdx.x * 8 + wave; r < TK; r += gridDim.x * 8) {
        const f32x4 y = *(const f32x4*)(P.in[2] + (size_t)(r - T) * 256 + 4 * lane);
        *(u32x2*)(CKVN + (size_t)r * 256 + 4 * lane) = (u32x2){pk2(y[0], y[1]), pk2(y[2], y[3])};
    }
}

__device__ __forceinline__ void rope32(float (&x)[32], const float2* rp) {
#pragma unroll
    for (int a = 0; a < 2; ++a)
#pragma unroll
        for (int i = 0; i < 8; ++i) { const float2 cs = rp[a * 8 + i]; const float x1 = x[16 * a + i], x2 = x[16 * a + 8 + i];
            x[16 * a + i] = x1 * cs.x - x2 * cs.y; x[16 * a + 8 + i] = x2 * cs.x + x1 * cs.y; }
}
__device__ __forceinline__ void p5_qknorm(const Params& P, unsigned char* smraw) {
    unsigned char* ws = P.ws;
    bf16_t* QR = (bf16_t*)(ws + W_QRAW); bf16_t* KV = (bf16_t*)(ws + W_KVRAW);
    const bf16_t* PB = (const bf16_t*)((unsigned char*)P.out + OS_PB);
    bf16_t* VTC = (bf16_t*)(ws + W_VTC); bf16_t* VTS = (bf16_t*)(ws + W_VTS);
    const float2* ROPE = (const float2*)(ws + W_ROPE);
    const float* qn = P.in[16]; const float* kn = P.in[17];
    const int t = tid_opaque();
    for (int it = blockIdx.x; it < TK / 64; it += gridDim.x) {
        const int r = it * 64 + (t >> 3), h = t & 7;
        const bool sample = (r >= TC && r < T);
        const float2* rp = ROPE + (size_t)((r - TC) & 4095) * 16;
        if (r < T) {
            u32x4* qp = (u32x4*)(QR + (size_t)r * 768 + h * 96);
            u32x4 raw[12]; float ss = 0.f;
#pragma unroll
            for (int i = 0; i < 12; ++i) { raw[i] = qp[i];
#pragma unroll
                for (int e = 0; e < 4; ++e) { const float a = bflo(raw[i][e]), b = bfhi(raw[i][e]); ss += a * a + b * b; } }
            const float rinv = rsqrtf(ss * (1.f / 96.f) + EPS), rs = rinv * QSCALE;
#pragma unroll
            for (int i = 0; i < 8; ++i) { u32x4 o;
#pragma unroll
                for (int e = 0; e < 4; ++e) o[e] = pk2(bflo(raw[i][e]) * rs * qn[i * 8 + 2 * e], bfhi(raw[i][e]) * rs * qn[i * 8 + 2 * e + 1]);
                qp[i] = o; }
            float x[32];
#pragma unroll
            for (int i = 0; i < 4; ++i)
#pragma unroll
                for (int e = 0; e < 4; ++e) { x[i * 8 + 2 * e] = bflo(raw[8 + i][e]) * rs * qn[64 + i * 8 + 2 * e]; x[i * 8 + 2 * e + 1] = bfhi(raw[8 + i][e]) * rs * qn[64 + i * 8 + 2 * e + 1]; }
            if (sample) rope32(x, rp);
#pragma unroll
            for (int i = 0; i < 4; ++i) { u32x4 o;
#pragma unroll
                for (int e = 0; e < 4; ++e) o[e] = pk2(x[i * 8 + 2 * e], x[i * 8 + 2 * e + 1]);
                qp[8 + i] = o; }
        }
        if (r < TC) {
            const bf16_t* ck = (const bf16_t*)(ws + W_CKV) + (size_t)r * 256 + h * 32;
            const float rinv = rsqrtf(((const float*)(ws + W_RS))[4 * T + r] * (1.f / 256.f) + EPS);
            float* oc = P.out + O_CKV + (size_t)r * 256 + h * 32;
#pragma unroll
            for (int i = 0; i < 4; ++i) { const u32x4 v = *(const u32x4*)(ck + i * 8); const f32x4 ka = *(const f32x4*)(P.in[14] + h * 32 + i * 8), kb = *(const f32x4*)(P.in[14] + h * 32 + i * 8 + 4);
                *(f32x4*)(oc + i * 8) = (f32x4){bflo(v[0]) * rinv * ka[0], bfhi(v[0]) * rinv * ka[1], bflo(v[1]) * rinv * ka[2], bfhi(v[1]) * rinv * ka[3]};
                *(f32x4*)(oc + i * 8 + 4) = (f32x4){bflo(v[2]) * rinv * kb[0], bfhi(v[2]) * rinv * kb[1], bflo(v[3]) * rinv * kb[2], bfhi(v[3]) * rinv * kb[3]}; }
            const u32x2 kr = *(const u32x2*)(PB + (size_t)r * PB_LD + PB_KROPE + h * 4);
            *(f32x4*)(P.out + O_KROPE + (size_t)r * 32 + h * 4) = (f32x4){bflo(kr[0]), bfhi(kr[0]), bflo(kr[1]), bfhi(kr[1])};
        }
        __builtin_amdgcn_sched_barrier(0);
        u32x4* kp = (u32x4*)(KV + (size_t)r * 1024 + h * 128);
        {
            constexpr int HS = 64 * 72 + 8;
            bf16_t* vs = (bf16_t*)smraw;
            u32x4 vv[8];
#pragma unroll
            for (int i = 0; i < 8; ++i) vv[i] = kp[8 + i];
            bf16_t* vw = vs + h * HS + (t >> 3);
#pragma unroll
            for (int i = 0; i < 8; ++i)
#pragma unroll
                for (int e = 0; e < 4; ++e) { vw[(i * 8 + 2 * e) * 72] = (bf16_t)(vv[i][e] & 0xffffu); vw[(i * 8 + 2 * e + 1) * 72] = (bf16_t)(vv[i][e] >> 16); }
            __syncthreads();
            const int rb = it * 64;
            bf16_t* vt; int lk;
            if (rb < TC) { vt = VTC + (size_t)((rb >> 8) * 8) * 64 * 256 + (rb & 255); lk = 256; }
            else if (rb < T) { const int rr = rb - TC; vt = VTS + (size_t)((rr >> 12) * 8) * 64 * LKS + 256 + (rr & 4095); lk = LKS; }
            else { const int rr = rb - T; vt = VTS + (size_t)((rr >> 8) * 8) * 64 * LKS + (rr & 255); lk = LKS; }
#pragma unroll
            for (int n = 0; n < 8; ++n) { const int vec = t + 512 * n, hd = vec >> 3, sg = vec & 7;
                const u32x4 x = *(const u32x4*)(vs + (hd >> 6) * HS + (hd & 63) * 72 + sg * 8);
                *(u32x4*)(vt + (size_t)hd * lk + sg * 8) = x; }
            __syncthreads();
        }
        __builtin_amdgcn_sched_barrier(0);
        {
            u32x4 raw[8]; float x[32]; float ss = 0.f;
#pragma unroll
            for (int i = 0; i < 8; ++i) { raw[i] = kp[i];
#pragma unroll
                for (int e = 0; e < 4; ++e) { const float a = bflo(raw[i][e]), b = bfhi(raw[i][e]); ss += a * a + b * b; } }
            if (r < T) {
                const u32x4* pp = (const u32x4*)(PB + (size_t)r * PB_LD + PB_KROPE);
#pragma unroll
                for (int i = 0; i < 4; ++i) { const u32x4 v = pp[i];
#pragma unroll
                    for (int e = 0; e < 4; ++e) { x[i * 8 + 2 * e] = bflo(v[e]); x[i * 8 + 2 * e + 1] = bfhi(v[e]); } }
            } else {
                const f32x4* pp = (const f32x4*)(P.in[3] + (size_t)(r - T) * 32);
#pragma unroll
                for (int i = 0; i < 8; ++i) { const f32x4 v = pp[i];
#pragma unroll
                    for (int e = 0; e < 4; ++e) x[i * 4 + e] = v[e]; }
            }
#pragma unroll
            for (int d = 0; d < 32; ++d) ss += x[d] * x[d];
            const float rinv = rsqrtf(ss * (1.f / 96.f) + EPS);
#pragma unroll
            for (int i = 0; i < 8; ++i) { u32x4 o;
#pragma unroll
                for (int e = 0; e < 4; ++e) o[e] = pk2(bflo(raw[i][e]) * rinv * kn[i * 8 + 2 * e], bfhi(raw[i][e]) * rinv * kn[i * 8 + 2 * e + 1]);
                kp[i] = o; }
#pragma unroll
            for (int d = 0; d < 32; ++d) x[d] = x[d] * rinv * kn[64 + d];
            if (sample) rope32(x, rp);
#pragma unroll
            for (int i = 0; i < 4; ++i) { u32x4 o;
#pragma unroll
                for (int e = 0; e < 4; ++e) o[e] = pk2(x[i * 8 + 2 * e], x[i * 8 + 2 * e + 1]);
                kp[8 + i] = o; }
        }
    }
}

constexpr int GL_GA = 0;
constexpr int GL_SEG = GL_GA + 64 * 32 * 4;
constexpr int GL_QR = GL_SEG + 8 * 64 * 4;
constexpr int GL_KR = GL_QR + 64 * 72 * 2;
constexpr int GL_QS = GL_KR + 64 * 72 * 2;
constexpr int GL_KS = GL_QS + 64 * 72 * 2;
constexpr int GL_SC = GL_KS + 64 * 72 * 2;
constexpr int GL_VT = GL_SC + 64 * 72 * 2;
constexpr int GL_ST = GL_VT + 128 * 72 * 2;
constexpr int GL_END = GL_ST + 2 * 128 * 72 * 2;
static_assert(GL_END <= 128 * 1024 && 64 * 132 * 4 <= 2 * 128 * 72 * 2, "GLA LDS");

__device__ __forceinline__ void gla_load_w(const Params& P, int h, int d, float (&w)[2][16], float (&bb)[2]) {
#pragma unroll
    for (int dir = 0; dir < 2; ++dir) {
#pragma unroll
        for (int r = 0; r < 16; ++r) w[dir][r] = P.in[18][(size_t)dir * 4096 + r * 256 + h * 64 + d];
        bb[dir] = P.in[19][dir * 256 + h * 64 + d]; }
}
__device__ __forceinline__ void gla_cum(const float (&w)[16], float b, int dir, unsigned char* sm, int d, int seg, float (&cum)[8], float& last) {
    const float* gaL = (const float*)(sm + GL_GA); float* segL = (float*)(sm + GL_SEG);
    float la[8];
#pragma unroll
    for (int ii = 0; ii < 8; ++ii) { float z = b; const float* g = gaL + (seg * 8 + ii) * 32 + dir * 16;
#pragma unroll
        for (int r = 0; r < 16; ++r) z += g[r] * w[r];
        la[ii] = (fminf(z, 0.f) - __logf(1.f + __expf(-fabsf(z)))) * (1.f / 16.f); }
    if (dir == 0) { cum[0] = la[0];
#pragma unroll
        for (int ii = 1; ii < 8; ++ii) cum[ii] = cum[ii - 1] + la[ii];
        segL[seg * 64 + d] = cum[7]; }
    else { cum[7] = la[7];
#pragma unroll
        for (int ii = 6; ii >= 0; --ii) cum[ii] = cum[ii + 1] + la[ii];
        segL[seg * 64 + d] = cum[0]; }
    __syncthreads();
    float off = 0.f, tot = 0.f;
#pragma unroll
    for (int s = 0; s < 8; ++s) { const float v = segL[s * 64 + d]; tot += v; if (dir == 0 ? (s < seg) : (s > seg)) off += v; }
#pragma unroll
    for (int ii = 0; ii < 8; ++ii) cum[ii] += off;
    last = tot;
}
__device__ __forceinline__ f32x16 mfma32(bf16x8 a, bf16x8 b, f32x16 c) { return __builtin_amdgcn_mfma_f32_32x32x16_bf16(a, b, c, 0, 0, 0); }
__device__ __forceinline__ f32x16 tile_mm64(const bf16_t* A, int m0, const bf16_t* Bt, int n0, f32x16 acc, int lane) {
    const int rr = lane & 31, hh = lane >> 5;
#pragma unroll
    for (int ks = 0; ks < 4; ++ks) { const bf16x8 a = *(const bf16x8*)(A + (m0 + rr) * 72 + ks * 16 + 8 * hh), b = *(const bf16x8*)(Bt + (n0 + rr) * 72 + ks * 16 + 8 * hh); acc = mfma32(a, b, acc); }
    return acc;
}
#define GLA_LD_GA(row0) (*(const u32x4*)(PB + (size_t)((row0) + (t >> 2)) * PB_LD + PB_GA + (t & 3) * 8))
#define GLA_LD_V(row0, n) (*(const u32x4*)(PB + (size_t)((row0) + ((t + 512 * (n)) >> 4)) * PB_LD + PB_GV + h * 128 + ((t + 512 * (n)) & 15) * 8))
#define GLA_LD_QK(row0, off) (*(const u32x4*)(PB + (size_t)((row0) + (t >> 3)) * PB_LD + (off) + h * 64 + (t & 7) * 8))
__device__ __forceinline__ void gla_stage_ga(unsigned char* sm, u32x4 r, int t) {
    if (t < 256) { float* g = (float*)(sm + GL_GA) + (t >> 2) * 32 + (t & 3) * 8;
        *(f32x4*)g = (f32x4){bflo(r[0]), bfhi(r[0]), bflo(r[1]), bfhi(r[1])}; *(f32x4*)(g + 4) = (f32x4){bflo(r[2]), bfhi(r[2]), bflo(r[3]), bfhi(r[3])}; }
}
#define GLA_LD_V16(row0, arr) do { const bf16_t* vp_ = PB + (size_t)((row0) + (t >> 7) * 16) * PB_LD + PB_GV + h * 128 + (t & 127); \
        _Pragma("unroll") for (int jj_ = 0; jj_ < 16; ++jj_) arr[jj_] = vp_[(size_t)jj_ * PB_LD]; } while (0)
__device__ __forceinline__ void gla_stage_v16(unsigned char* sm, const bf16_t (&a)[16], int t) {
    bf16_t* vT = (bf16_t*)(sm + GL_VT) + (t & 127) * 72 + (t >> 7) * 16;
    *(u32x4*)vT = (u32x4){(unsigned)a[0] | ((unsigned)a[1] << 16), (unsigned)a[2] | ((unsigned)a[3] << 16), (unsigned)a[4] | ((unsigned)a[5] << 16), (unsigned)a[6] | ((unsigned)a[7] << 16)};
    *(u32x4*)(vT + 8) = (u32x4){(unsigned)a[8] | ((unsigned)a[9] << 16), (unsigned)a[10] | ((unsigned)a[11] << 16), (unsigned)a[12] | ((unsigned)a[13] << 16), (unsigned)a[14] | ((unsigned)a[15] << 16)};
}
__device__ __forceinline__ void gla_stage_vT(unsigned char* sm, u32x4 r, int p) {
    bf16_t* vT = (bf16_t*)(sm + GL_VT) + (p & 15) * 8 * 72 + (p >> 4);
#pragma unroll
    for (int e = 0; e < 4; ++e) { vT[(2 * e) * 72] = (bf16_t)(r[e] & 0xffffu); vT[(2 * e + 1) * 72] = (bf16_t)(r[e] >> 16); }
}

__device__ __forceinline__ void gla_pass1(const Params& P, unsigned char* sm) {
    const bf16_t* PB = (const bf16_t*)((unsigned char*)P.out + OS_PB);
    bf16_t* DS = (bf16_t*)(P.ws + W_DS); float* E = (float*)((unsigned char*)P.out + OS_E);
    const int t = tid_opaque(), lane = t & 63, wv = t >> 6, d = t & 63, seg = t >> 6;
    bf16_t* kT = (bf16_t*)(sm + GL_KS); const bf16_t* vT = (const bf16_t*)(sm + GL_VT); const bf16_t* kr = (const bf16_t*)(sm + GL_KR);
    int hw = -1; float w[2][16], bb[2];
    const bool bal = (gridDim.x == 256); const int c = blockIdx.x;
    const int nit = !bal ? (1536 + (int)gridDim.x - 1 - c) / (int)gridDim.x : (c < 144 ? 5 : (c < 176 ? 8 : 7));
    for (int k = 0; k < nit; ++k) {
        const int item = !bal ? c + k * (int)gridDim.x : (k < 6 ? c + 256 * k : (k == 6 ? 1280 + (c - 144) : 1392 + (c - 144)));
        const int cgk = item >> 2, h = item & 3, row0 = cgk * 64;
        if (h != hw) { gla_load_w(P, h, d, w, bb); hw = h; }
        { u32x4 rga = {0u, 0u, 0u, 0u}; if (t < 256) rga = GLA_LD_GA(row0); const u32x4 rk = GLA_LD_QK(row0, PB_GK); bf16_t rv[16]; GLA_LD_V16(row0, rv);
          gla_stage_ga(sm, rga, t); gla_stage_v16(sm, rv, t);
          *(u32x4*)(sm + GL_KR + ((t >> 3) * 72 + (t & 7) * 8) * 2) = rk; }
        __syncthreads();
        for (int dir = 0; dir < 2; ++dir) {
            float cum[8], last;
            gla_cum(w[dir], bb[dir], dir, sm, d, seg, cum, last);
            unsigned pk[4];
#pragma unroll
            for (int jj = 0; jj < 4; ++jj) {
                const float k0 = bf2f(kr[(seg * 8 + 2 * jj) * 72 + d]) * __expf(last - cum[2 * jj]);
                const float k1 = bf2f(kr[(seg * 8 + 2 * jj + 1) * 72 + d]) * __expf(last - cum[2 * jj + 1]);
                pk[jj] = pk2(k0, k1); }
            *(u32x4*)(kT + d * 72 + seg * 8) = (u32x4){pk[0], pk[1], pk[2], pk[3]};
            if (seg == 0) E[(size_t)(item * 2 + dir) * 64 + d] = __expf(last);
            __syncthreads();
            const int mt = wv >> 1, nt = wv & 1;
            f32x16 acc;
#pragma unroll
            for (int i = 0; i < 16; ++i) acc[i] = 0.f;
            acc = tile_mm64(vT, mt * 32, kT, nt * 32, acc, lane);
            bf16_t* o = DS + (size_t)(item * 2 + dir) * 8192 + nt * 32 + (lane & 31);
#pragma unroll
            for (int i = 0; i < 16; ++i) o[(size_t)(mt * 32 + (i & 3) + 8 * (i >> 2) + 4 * (lane >> 5)) * 64] = f2bf(acc[i]);
            __syncthreads();
        }
    }
}

template <int NC, int BATCH>
__device__ __forceinline__ void gla_scan_chain(bf16_t* DS, const float* E, int cg0, int h, int dir, int e, float s0, float s1, float* fin) {
    const int dk = e & 63, dv = e >> 6;
    for (int st0 = 0; st0 < NC; st0 += BATCH) {
        unsigned ds[BATCH]; float2 ee[BATCH];
#pragma unroll
        for (int i = 0; i < BATCH; ++i) { const int st = st0 + i, c = dir == 0 ? st : NC - 1 - st; const size_t idx = (size_t)((cg0 + c) * 4 + h) * 2 + dir;
            ds[i] = *(const unsigned*)(DS + idx * 8192 + e); ee[i] = *(const float2*)(E + idx * 64 + dk); }
#pragma unroll
        for (int i = 0; i < BATCH; ++i) { const int st = st0 + i, c = dir == 0 ? st : NC - 1 - st; const size_t idx = (size_t)((cg0 + c) * 4 + h) * 2 + dir;
            *(unsigned*)(DS + idx * 8192 + e) = pk2(s0, s1);
            s0 = ee[i].x * s0 + bflo(ds[i]); s1 = ee[i].y * s1 + bfhi(ds[i]); }
    }
    if (fin) { fin[dk * 128 + dv] = s0; fin[(dk + 1) * 128 + dv] = s1; }
}
__device__ __forceinline__ void gla_pass2(const Params& P) {
    bf16_t* DS = (bf16_t*)(P.ws + W_DS); const float* E = (const float*)((unsigned char*)P.out + OS_E);
    const int t = tid_opaque();
    for (int it = blockIdx.x; it < 256; it += gridDim.x) {
        if (it < 256) { const int part = it & 7, dir = (it >> 3) & 1, h = (it >> 4) & 3, b = it >> 6, e = (part * 512 + t) * 2;
            const float* s0p = P.in[4] + (size_t)((b * 2 + dir) * 4 + h) * 8192 + (e & 63) * 128 + (e >> 6);
            gla_scan_chain<64, 16>(DS, E, 128 + b * 64, h, dir, e, s0p[0], s0p[128], nullptr);
        } else { const int i2 = it - 256, part = i2 & 7, dir = (i2 >> 3) & 1, h = (i2 >> 4) & 3, b = i2 >> 6, e = (part * 512 + t) * 2;
            gla_scan_chain<4, 4>(DS, E, b * 4, h, dir, e, 0.f, 0.f, P.out + O_STATE + (size_t)((b * 2 + dir) * 4 + h) * 8192);
        }
    }
    for (int it0 = blockIdx.x * 4; it0 < 2048; it0 += gridDim.x * 4) {
        unsigned ds[4][4]; float2 ee[4][4];
#pragma unroll
        for (int q = 0; q < 4; ++q) { const int i2 = it0 + q, part = i2 & 7, dir = (i2 >> 3) & 1, h = (i2 >> 4) & 3, b = i2 >> 6, e = (part * 512 + t) * 2;
#pragma unroll
            for (int st = 0; st < 4; ++st) { const int c = dir == 0 ? st : 3 - st; const size_t idx = (size_t)((b * 4 + c) * 4 + h) * 2 + dir;
                ds[q][st] = *(const unsigned*)(DS + idx * 8192 + e); ee[q][st] = *(const float2*)(E + idx * 64 + (e & 63)); } }
#pragma unroll
        for (int q = 0; q < 4; ++q) { const int i2 = it0 + q, part = i2 & 7, dir = (i2 >> 3) & 1, h = (i2 >> 4) & 3, b = i2 >> 6, e = (part * 512 + t) * 2;
            float s0 = 0.f, s1 = 0.f;
#pragma unroll
            for (int st = 0; st < 4; ++st) { const int c = dir == 0 ? st : 3 - st; const size_t idx = (size_t)((b * 4 + c) * 4 + h) * 2 + dir;
                *(unsigned*)(DS + idx * 8192 + e) = pk2(s0, s1);
                s0 = ee[q][st].x * s0 + bflo(ds[q][st]); s1 = ee[q][st].y * s1 + bfhi(ds[q][st]); }
            float* fin = P.out + O_STATE + (size_t)((b * 2 + dir) * 4 + h) * 8192;
            fin[(e & 63) * 128 + (e >> 6)] = s0; fin[((e & 63) + 1) * 128 + (e >> 6)] = s1; }
    }
}

__device__ __forceinline__ void gla_pass3(const Params& P, unsigned char* sm) {
    const bf16_t* PB = (const bf16_t*)((unsigned char*)P.out + OS_PB);
    const bf16_t* SP = (const bf16_t*)(P.ws + W_DS);
    bf16_t* ATT = (bf16_t*)(P.ws + W_R1);
    const float* gn = P.in[20];
    const int t = tid_opaque(), lane = t & 63, wv = t >> 6, d = t & 63, seg = t >> 6;
    const bf16_t* qr = (const bf16_t*)(sm + GL_QR); const bf16_t* kr = (const bf16_t*)(sm + GL_KR);
    bf16_t* qs = (bf16_t*)(sm + GL_QS); bf16_t* ks = (bf16_t*)(sm + GL_KS); bf16_t* sc = (bf16_t*)(sm + GL_SC);
    const bf16_t* vT = (const bf16_t*)(sm + GL_VT); bf16_t* ST = (bf16_t*)(sm + GL_ST); float* ob = (float*)(sm + GL_ST);
    int hw = -1; float w[2][16], bb[2];
    u32x4 rga = {0u, 0u, 0u, 0u}, rq, rk, rs00, rs01, rs10, rs11, rg0, rg1; bf16_t rv[16];
#define G3_LOAD(it_) do { const int h = (it_) & 3, row0_ = ((it_) >> 2) * 64; \
        if (t < 256) rga = GLA_LD_GA(row0_); GLA_LD_V16(row0_, rv); rq = GLA_LD_QK(row0_, PB_GQ); rk = GLA_LD_QK(row0_, PB_GK); \
        const bf16_t* sp_ = SP + (size_t)((it_) * 2) * 8192 + (size_t)t * 8; rs00 = *(const u32x4*)sp_; rs01 = *(const u32x4*)(sp_ + 4096); rs10 = *(const u32x4*)(sp_ + 8192); rs11 = *(const u32x4*)(sp_ + 8192 + 4096); \
        const bf16_t* gp_ = PB + (size_t)(row0_ + (t >> 3)) * PB_LD + PB_GG + h * 128 + (t & 7) * 16; rg0 = *(const u32x4*)gp_; rg1 = *(const u32x4*)(gp_ + 8); } while (0)
    int item = blockIdx.x;
    if (item < 1536) G3_LOAD(item);
    for (; item < 1536; item += gridDim.x) {
        const int cgk = item >> 2, h = item & 3, row0 = cgk * 64;
        if (h != hw) { gla_load_w(P, h, d, w, bb); hw = h; }
        gla_stage_ga(sm, rga, t); gla_stage_v16(sm, rv, t);
        *(u32x4*)(sm + GL_QR + ((t >> 3) * 72 + (t & 7) * 8) * 2) = rq;
        *(u32x4*)(sm + GL_KR + ((t >> 3) * 72 + (t & 7) * 8) * 2) = rk;
        *(u32x4*)(ST + (t >> 3) * 72 + (t & 7) * 8) = rs00; *(u32x4*)(ST + (64 + (t >> 3)) * 72 + (t & 7) * 8) = rs01;
        *(u32x4*)(ST + 128 * 72 + (t >> 3) * 72 + (t & 7) * 8) = rs10; *(u32x4*)(ST + 128 * 72 + (64 + (t >> 3)) * 72 + (t & 7) * 8) = rs11;
        const u32x4 g0 = rg0, g1 = rg1;
        __syncthreads();
        if (item + (int)gridDim.x < 1536) G3_LOAD(item + (int)gridDim.x);
        f32x16 oacc;
#pragma unroll
        for (int i = 0; i < 16; ++i) oacc[i] = 0.f;
        for (int dir = 0; dir < 2; ++dir) {
            float cum[8], last;
            gla_cum(w[dir], bb[dir], dir, sm, d, seg, cum, last);
#pragma unroll
            for (int ii = 0; ii < 8; ++ii) { const int o_ = (seg * 8 + ii) * 72 + d;
                qs[o_] = f2bf(bf2f(qr[o_]) * 0.125f * __expf(cum[ii]));
                ks[o_] = f2bf(bf2f(kr[o_]) * __expf(-cum[ii])); }
            __syncthreads();
            if (wv < 4) { const int mt = wv >> 1, nt = wv & 1;
                f32x16 s_;
#pragma unroll
                for (int i = 0; i < 16; ++i) s_[i] = 0.f;
                s_ = tile_mm64(qs, mt * 32, ks, nt * 32, s_, lane);
                const int j = nt * 32 + (lane & 31);
#pragma unroll
                for (int i = 0; i < 16; ++i) { const int ir = mt * 32 + (i & 3) + 8 * (i >> 2) + 4 * (lane >> 5);
                    const bool keep = dir == 0 ? (j <= ir) : (j >= ir);
                    sc[ir * 72 + j] = f2bf(keep ? s_[i] : 0.f); } }
            __syncthreads();
            { const int mt = wv >> 2, nt = wv & 3;
              oacc = tile_mm64(sc, mt * 32, vT, nt * 32, oacc, lane);
              oacc = tile_mm64(qs, mt * 32, ST + dir * 128 * 72, nt * 32, oacc, lane); }
            __syncthreads();
        }
        { const int mt = wv >> 2, nt = wv & 3;
#pragma unroll
          for (int i = 0; i < 16; ++i) ob[(mt * 32 + (i & 3) + 8 * (i >> 2) + 4 * (lane >> 5)) * 132 + nt * 32 + (lane & 31)] = oacc[i]; }
        __syncthreads();
        { const int i = t >> 3, sub = t & 7; float v[16]; float ss = 0.f;
#pragma unroll
          for (int c = 0; c < 16; ++c) { v[c] = ob[i * 132 + sub * 16 + c]; ss += v[c] * v[c]; }
          ss += __shfl_xor(ss, 1); ss += __shfl_xor(ss, 2); ss += __shfl_xor(ss, 4);
          const float rinv = rsqrtf(ss * (1.f / 128.f) + EPS);
          unsigned o[8];
#pragma unroll
          for (int c = 0; c < 8; ++c) { const unsigned gw = c < 4 ? g0[c & 3] : g1[c & 3]; const float ga = bflo(gw), gb = bfhi(gw);
              const float y0 = v[2 * c] * rinv * gn[sub * 16 + 2 * c] * ga * sigmoidf_(ga), y1 = v[2 * c + 1] * rinv * gn[sub * 16 + 2 * c + 1] * gb * sigmoidf_(gb);
              o[c] = pk2(y0, y1); }
          u32x4* op = (u32x4*)(ATT + (size_t)(row0 + i) * 1024 + 512 + h * 128 + sub * 16);
          op[0] = (u32x4){o[0], o[1], o[2], o[3]}; op[1] = (u32x4){o[4], o[5], o[6], o[7]}; }
        __syncthreads();
    }
#undef G3_LOAD
}

constexpr int AT_KS = 0;
constexpr int AT_VS = AT_KS + 2 * 64 * 104 * 2;
template <int QT>
__device__ __forceinline__ void attn_item(const bf16_t* Q, const bf16_t* KV, const bf16_t* vt, bf16_t* ATT, bf16_t* Ks, bf16_t* Vs,
                                          int h, int q0, int nkt, int lk, int krow_a, int krow_b, float negCB, int t) {
    const int lane = t & 63, wv = t >> 6, rr = lane & 31, hh = lane >> 5;
    const int kkey0 = t / 12, kseg0 = t % 12, kkey1 = (512 + t) / 12, kseg1 = (512 + t) % 12, vdv = t >> 3, vseg = t & 7;
    u32x4 kr0, kr1 = {0u, 0u, 0u, 0u}, vr;
#define AT_LOAD(kt) do { const int kb = ((kt) < 4 ? krow_a + (kt) * 64 : krow_b + ((kt) - 4) * 64); \
        kr0 = *(const u32x4*)(KV + (size_t)(kb + kkey0) * 1024 + h * 128 + kseg0 * 8); \
        if (t < 256) kr1 = *(const u32x4*)(KV + (size_t)(kb + kkey1) * 1024 + h * 128 + kseg1 * 8); \
        vr = *(const u32x4*)(vt + (size_t)vdv * lk + (kt) * 64 + vseg * 8); } while (0)
    AT_LOAD(0);
    bf16x8 qf[QT][6];
#pragma unroll
    for (int qt = 0; qt < QT; ++qt) { const bf16_t* qp = Q + (size_t)(q0 + (wv * QT + qt) * 32 + rr) * 768 + h * 96 + 8 * hh;
#pragma unroll
        for (int ks = 0; ks < 6; ++ks) qf[qt][ks] = *(const bf16x8*)(qp + ks * 16); }
    f32x16 O[QT][2];
    float lsum[QT];
#pragma unroll
    for (int qt = 0; qt < QT; ++qt) { lsum[qt] = 0.f;
#pragma unroll
        for (int i = 0; i < 16; ++i) { O[qt][0][i] = 0.f; O[qt][1][i] = 0.f; } }
    for (int kt = 0; kt < nkt; ++kt) {
        bf16_t* Kb = Ks + (kt & 1) * 64 * 104; bf16_t* Vb = Vs + (kt & 1) * 64 * 72;
        *(u32x4*)(Kb + kkey0 * 104 + kseg0 * 8) = kr0;
        if (t < 256) *(u32x4*)(Kb + kkey1 * 104 + kseg1 * 8) = kr1;
        *(u32x4*)(Vb + vdv * 72 + vseg * 8) = vr;
        __syncthreads();
        if (kt + 1 < nkt) AT_LOAD(kt + 1);
#pragma unroll 1
        for (int sub = 0; sub < 2; ++sub) {
            f32x16 s[QT];
#pragma unroll
            for (int qt = 0; qt < QT; ++qt)
#pragma unroll
                for (int i = 0; i < 16; ++i) s[qt][i] = negCB;
#pragma unroll
            for (int ks = 0; ks < 6; ++ks) { const bf16x8 a = *(const bf16x8*)(Kb + (sub * 32 + rr) * 104 + ks * 16 + 8 * hh);
#pragma unroll
                for (int qt = 0; qt < QT; ++qt) s[qt] = mfma32(a, qf[qt][ks], s[qt]); }
            bf16x8 pb[QT][2];
#pragma unroll
            for (int qt = 0; qt < QT; ++qt) {
#pragma unroll
                for (int i = 0; i < 16; ++i) { s[qt][i] = __builtin_amdgcn_exp2f(s[qt][i]); lsum[qt] += s[qt][i]; }
                const u32x4 p0 = {pk2(s[qt][0], s[qt][1]), pk2(s[qt][2], s[qt][3]), pk2(s[qt][4], s[qt][5]), pk2(s[qt][6], s[qt][7])};
                const u32x4 p1 = {pk2(s[qt][8], s[qt][9]), pk2(s[qt][10], s[qt][11]), pk2(s[qt][12], s[qt][13]), pk2(s[qt][14], s[qt][15])};
                pb[qt][0] = __builtin_bit_cast(bf16x8, p0); pb[qt][1] = __builtin_bit_cast(bf16x8, p1); }
#pragma unroll
            for (int j = 0; j < 2; ++j)
#pragma unroll
                for (int dvt = 0; dvt < 2; ++dvt) {
                    const u32x2 a0 = *(const u32x2*)(Vb + (dvt * 32 + rr) * 72 + sub * 32 + 16 * j + 4 * hh), a1 = *(const u32x2*)(Vb + (dvt * 32 + rr) * 72 + sub * 32 + 16 * j + 8 + 4 * hh);
                    const u32x4 av = {a0[0], a0[1], a1[0], a1[1]};
                    const bf16x8 a = __builtin_bit_cast(bf16x8, av);
#pragma unroll
                    for (int qt = 0; qt < QT; ++qt) O[qt][dvt] = mfma32(a, pb[qt][j], O[qt][dvt]);
                }
        }
    }
#undef AT_LOAD
#pragma unroll
    for (int qt = 0; qt < QT; ++qt) {
        float l = lsum[qt]; l += __shfl_xor(l, 32);
        const float inv = 1.f / l;
        bf16_t* op = ATT + (size_t)(q0 + (wv * QT + qt) * 32 + rr) * 1024 + h * 64 + 4 * hh;
#pragma unroll
        for (int g = 0; g < 4; ++g) {
            *(u32x2*)(op + 8 * g) = (u32x2){pk2(O[qt][0][4 * g] * inv, O[qt][0][4 * g + 1] * inv), pk2(O[qt][0][4 * g + 2] * inv, O[qt][0][4 * g + 3] * inv)};
            *(u32x2*)(op + 32 + 8 * g) = (u32x2){pk2(O[qt][1][4 * g] * inv, O[qt][1][4 * g + 1] * inv), pk2(O[qt][1][4 * g + 2] * inv, O[qt][1][4 * g + 3] * inv)};
        }
    }
    __syncthreads();
}
__device__ __forceinline__ void attn_phase(const Params& P, unsigned char* sm) {
    unsigned char* ws = P.ws;
    const bf16_t* Q = (const bf16_t*)(ws + W_QRAW); const bf16_t* KV = (const bf16_t*)(ws + W_KVRAW);
    const bf16_t* VTC = (const bf16_t*)(ws + W_VTC); const bf16_t* VTS = (const bf16_t*)(ws + W_VTS);
    bf16_t* ATT = (bf16_t*)(ws + W_R1);
    const int t = tid_opaque();
    bf16_t* Ks = (bf16_t*)(sm + AT_KS); bf16_t* Vs = (bf16_t*)(sm + AT_VS);
    float negCB;
    { float mq = 0.f, mk = 0.f;
      for (int d = 0; d < 96; ++d) { mq = fmaxf(mq, fabsf(P.in[16][d])); mk = fmaxf(mk, fabsf(P.in[17][d])); }
      negCB = -1.02f * 96.f * mq * mk * QSCALE; }
    for (int item0 = blockIdx.x; item0 < 256; item0 += gridDim.x) {
        const int item = (gridDim.x == 256) ? (item0 & 7) * 32 + (item0 >> 3) : item0;
        const int qb = item & 7, h = (item >> 3) & 7, b = item >> 6;
        attn_item<2>(Q, KV, VTS + (size_t)(b * 8 + h) * 64 * LKS, ATT, Ks, Vs, h, TC + b * 4096 + qb * 512, 68, LKS, T + b * 256, TC + b * 4096, negCB, t);
    }
    for (int item = blockIdx.x; item < 256; item += gridDim.x) {
        const int h = item & 7, b = item >> 3;
        attn_item<1>(Q, KV, VTC + (size_t)(b * 8 + h) * 64 * 256, ATT, Ks, Vs, h, b * 256, 4, 256, b * 256, 0, negCB, t);
    }
}

__device__ __forceinline__ void dwconv_phase(const Params& P, unsigned char* smraw) {
    const bf16_t* U = (const bf16_t*)(P.ws + W_R1); bf16_t* U2 = (bf16_t*)(P.ws + W_R1 + (size_t)T * 1024 * 2);
    float* red = (float*)smraw;
    const int t = tid_opaque(), lane = t & 63, wv = t >> 6, c = 2 * t;
    float* wl = (float*)(smraw + 1024);
    for (int i = t; i < 31 * 1024 / 4; i += 512) ((f32x4*)wl)[i] = ((const f32x4*)P.in[24])[i];
    __syncthreads();
    const float2 bdw = *(const float2*)(P.in[25] + c), lg = *(const float2*)(P.in[26] + c), lb = *(const float2*)(P.in[27] + c);
    const int rows_per = (T / 8 + (int)gridDim.x - 1) / (int)gridDim.x * 8;
    const int R0 = blockIdx.x * rows_per, R1 = (R0 + rows_per < T) ? R0 + rows_per : T;
    unsigned win[38], nxt[8];
#pragma unroll
    for (int k = 0; k < 38; ++k) { const int r = R0 - 15 + k; win[k] = 0u; if (r >= 0 && r < T) win[k] = *(const unsigned*)(U + (size_t)r * 1024 + c); }
    int par = 0;
    for (int r0 = R0; r0 < R1; r0 += 8, par ^= 1) {
        int s0, s1;
        if (r0 < TC) { s0 = r0 & ~255; s1 = s0 + 256; } else { s0 = TC + ((r0 - TC) & ~4095); s1 = s0 + 4096; }
#pragma unroll
        for (int k = 0; k < 8; ++k) { const int r = r0 + 23 + k; nxt[k] = 0u; if (r < T) nxt[k] = *(const unsigned*)(U + (size_t)r * 1024 + c); }
        float a0[8], a1[8];
#pragma unroll
        for (int o = 0; o < 8; ++o) { a0[o] = bdw.x; a1[o] = bdw.y; }
        float x0[38], x1[38];
#pragma unroll
        for (int k = 0; k < 38; ++k) { const int r = r0 - 15 + k; const bool ok = (r >= s0 && r < s1); x0[k] = ok ? bflo(win[k]) : 0.f; x1[k] = ok ? bfhi(win[k]) : 0.f; }
#pragma unroll
        for (int j = 0; j < 31; ++j) { const float2 w = *(const float2*)(wl + j * 1024 + c);
#pragma unroll
            for (int o = 0; o < 8; ++o) { a0[o] += x0[o + j] * w.x; a1[o] += x1[o + j] * w.y; } }
        float* rd = red + par * 128;
#pragma unroll
        for (int o = 0; o < 8; ++o) { const float s1_ = wave_sum(a0[o] + a1[o]), s2_ = wave_sum(a0[o] * a0[o] + a1[o] * a1[o]);
            if (lane == 0) { rd[wv * 16 + o] = s1_; rd[wv * 16 + 8 + o] = s2_; } }
        __syncthreads();
#pragma unroll
        for (int o = 0; o < 8; ++o) { float m = 0.f, v = 0.f;
#pragma unroll
            for (int w = 0; w < 8; ++w) { m += rd[w * 16 + o]; v += rd[w * 16 + 8 + o]; }
            m *= (1.f / 1024.f); v = v * (1.f / 1024.f) - m * m;
            const float rinv = rsqrtf(fmaxf(v, 0.f) + EPS);
            const float y0 = (a0[o] - m) * rinv * lg.x + lb.x, y1 = (a1[o] - m) * rinv * lg.y + lb.y;
            *(unsigned*)(U2 + (size_t)(r0 + o) * 1024 + c) = pk2(y0 * sigmoidf_(y0), y1 * sigmoidf_(y1)); }
#pragma unroll
        for (int k = 0; k < 30; ++k) win[k] = win[k + 8];
#pragma unroll
        for (int k = 0; k < 8; ++k) win[30 + k] = nxt[k];
    }
    __syncthreads();
}

#define XB_TMO      128
#define XB_XCNT(j)  (256  + 64 * (j))
#define XB_XSUB(j)  (1280 + 64 * (j))
#define XB_XGEN(j)  (2304 + 64 * (j))
#define XB_TOP      3328
#define XB_TOPGEN   3392
#define XCD_BAR_WORDS 3456
static_assert(XCD_BAR_WORDS * 4 <= 16384, "barrier words");
#define XB_SPIN_CAP (1u << 18)

__device__ __forceinline__ unsigned xb_ld(unsigned* p)              { return __hip_atomic_load(p, __ATOMIC_RELAXED, __HIP_MEMORY_SCOPE_AGENT); }
__device__ __forceinline__ unsigned xb_add(unsigned* p, unsigned v) { return __hip_atomic_fetch_add(p, v, __ATOMIC_RELAXED, __HIP_MEMORY_SCOPE_AGENT); }
__device__ __forceinline__ unsigned xb_xcc_id() { return (unsigned)__builtin_amdgcn_s_getreg((3 << 11) | 20) & 0xFu; }
#define XB_SPIN(cond, bar) do { unsigned _sp = 0; while (cond) { __builtin_amdgcn_s_sleep(1); \
    if ((++_sp & 255u) == 0u) { if (xb_ld(&(bar)[XB_TMO])) break; if (_sp > XB_SPIN_CAP) { atomicAdd(&(bar)[XB_TMO], 1u); break; } } } } while (0)

struct XcdBarrier {
    unsigned* bar; unsigned x;
    volatile LAS unsigned* st;
};

__device__ __forceinline__ XcdBarrier xcd_barrier_post(unsigned* bar, volatile LAS unsigned* st) {
    XcdBarrier b; b.bar = bar; b.x = xb_xcc_id(); b.st = st;
    if (threadIdx.x == 0) (void)xb_add(&bar[XB_XCNT(b.x)], 1u);
    return b;
}
__device__ __forceinline__ void xcd_barrier_complete(unsigned* bar, unsigned x, unsigned& nloc, unsigned& nx) {
    const unsigned G = gridDim.x * gridDim.y * gridDim.z;
    unsigned sum, cnt, mine, sp = 0u;
    for (;;) {
        sum = 0u; cnt = 0u; mine = 0u;
#pragma unroll
        for (unsigned j = 0; j < 16; ++j) { const unsigned c = xb_ld(&bar[XB_XCNT(j)]); sum += c; cnt += (c > 0u) ? 1u : 0u; mine = (j == x) ? c : mine; }
        if (sum == G) break;
        __builtin_amdgcn_s_sleep(1);
        if ((++sp & 255u) == 0u) { if (xb_ld(&bar[XB_TMO])) break; if (sp > XB_SPIN_CAP) { atomicAdd(&bar[XB_TMO], 1u); break; } }
    }
    nloc = mine > 0u ? mine : 1u; nx = cnt > 0u ? cnt : 1u;
}

__device__ __forceinline__ void xcd_barrier(const XcdBarrier& b) {
    asm volatile("s_waitcnt vmcnt(0)" ::: "memory");
    __syncthreads();
    if (threadIdx.x == 0) {
        unsigned* bar = b.bar;
        __builtin_amdgcn_s_waitcnt(0);
        unsigned nloc = b.st[0], nx = b.st[1];
        if (nloc == 0u) { xcd_barrier_complete(bar, b.x, nloc, nx); b.st[0] = nloc; b.st[1] = nx; }
        const unsigned old = xb_add(&bar[XB_XSUB(b.x)], 1u);
        const unsigned gen = old / nloc;
        if (old + 1u == (gen + 1u) * nloc) {
            __builtin_amdgcn_fence(__ATOMIC_RELEASE, "agent");
            asm volatile("s_waitcnt vmcnt(0)" ::: "memory");
            const unsigned og = xb_add(&bar[XB_TOP], 1u);
            const unsigned tg = og / nx;
            if (og + 1u == (tg + 1u) * nx) xb_add(&bar[XB_TOPGEN], 1u);
            else XB_SPIN(xb_ld(&bar[XB_TOPGEN]) == tg, bar);
            __builtin_amdgcn_fence(__ATOMIC_ACQUIRE, "agent");
            xb_add(&bar[XB_XGEN(b.x)], 1u);
            asm volatile("s_waitcnt vmcnt(0)" ::: "memory");
        } else {
            XB_SPIN(xb_ld(&bar[XB_XGEN(b.x)]) == gen, bar);
            __builtin_amdgcn_fence(__ATOMIC_ACQUIRE, "agent");
            asm volatile("s_waitcnt vmcnt(0)" ::: "memory");
        }
    }
    __syncthreads();
}


constexpr int LDS_BYTES = 128 * 1024 + 256;
#ifndef NREP_ATT
#define NREP_ATT 1
#endif
#ifndef NREP_G1
#define NREP_G1 1
#endif
#ifndef NREP_G3
#define NREP_G3 1
#endif


#ifdef PROBE_E
#define PROBE_SYNC grid.sync(); __builtin_amdgcn_fence(__ATOMIC_ACQUIRE, "agent"); asm volatile("s_waitcnt vmcnt(0)" ::: "memory");
#else
#define PROBE_SYNC
#endif
__global__ void __launch_bounds__(512, 2) fwd_megakernel(Params P) {
    extern __shared__ __attribute__((aligned(16))) unsigned char lds[];
    cg::grid_group grid = cg::this_grid();
    unsigned char* ws = P.ws;
    const float* MOD = (const float*)(ws + W_MOD);
    bf16_t* H = (bf16_t*)(ws + W_R1);
    float* Y = P.out;
    const int G = gridDim.x, bx = blockIdx.x;
    pg8::StaticOrder S;
    volatile LAS unsigned* xst = (volatile LAS unsigned*)((LAS unsigned char*)lds + 128 * 1024);
    if (threadIdx.x < 2) xst[threadIdx.x] = 0u;
    __syncthreads();
    XcdBarrier xbar = xcd_barrier_post((unsigned*)(ws + W_BAR), xst);
#define GSYNC() xcd_barrier(xbar)

#ifndef NO_P0
    p0_prologue(P, lds);
#endif
    if (gridDim.x > 65536u) grid.sync();
    GSYNC();
    norm_phase(P.in[0], P.in[1] - (size_t)TC * 1024, P.in[9], MOD, 0, H);
    p1_aux(P);
    GSYNC();

    { pg8::Gemm g{H, (const bf16_t*)(ws + W_WIN), T, 2304, 1024}; S.init(T, 2304, G, bx);
      pg8::EpiProj E{(bf16_t*)(ws + W_CQ), (bf16_t*)(ws + W_CKV), (bf16_t*)((unsigned char*)P.out + OS_PB), PB_LD, (float*)(ws + W_RS) + 3 * T, (float*)(ws + W_RS) + 4 * T};
      pg8::gemm_phase((LAS unsigned char*)lds, g, S, E); }
    GSYNC();
    { pg8::Gemm g{(const bf16_t*)(ws + W_CQ), (const bf16_t*)(ws + W_WUQ), T, 768, 384}; S.init(T, 768, G, bx);
      pg8::EpiBf16Scaled E{(bf16_t*)(ws + W_QRAW), 768, (const float*)(ws + W_RS) + 3 * T, 1.f / 384.f, T};
      pg8::gemm_phase((LAS unsigned char*)lds, g, S, E); }
    { pg8::Gemm g{(const bf16_t*)(ws + W_CKV), (const bf16_t*)(ws + W_WUKV), TK, 1024, 256}; S.init(TK, 1024, G, G - 1 - bx);
      pg8::EpiBf16Scaled E{(bf16_t*)(ws + W_KVRAW), 1024, (const float*)(ws + W_RS) + 4 * T, 1.f / 256.f, T};
      pg8::gemm_phase((LAS unsigned char*)lds, g, S, E); }
    GSYNC();
#ifndef NO_P5
    p5_qknorm(P, lds);
#endif
#ifndef NO_G1
    { int nrep = NREP_G1; asm volatile("" : "+s"(nrep));
#pragma unroll 1
      for (int rep = 0; rep < nrep; ++rep) gla_pass1(P, lds); }
#endif
    GSYNC();
#ifdef STOP5
    return;
#endif
#ifndef NO_G2
    gla_pass2(P);
#endif
    GSYNC();
#ifdef STOP6
    for (size_t i = (size_t)blockIdx.x * 512 + threadIdx.x; i < (size_t)T * 256; i += (size_t)gridDim.x * 512) ((f32x4*)Y)[i] = (f32x4){0.f, 0.f, 0.f, 0.f};
    return;
#endif
#ifndef NO_AT
    { int nrep = NREP_ATT; asm volatile("" : "+s"(nrep));
#pragma unroll 1
      for (int rep = 0; rep < nrep; ++rep) attn_phase(P, lds); }
#endif
#ifndef NO_G3
    { int nrep = NREP_G3; asm volatile("" : "+s"(nrep));
#pragma unroll 1
      for (int rep = 0; rep < nrep; ++rep) gla_pass3(P, lds); }
#endif
    GSYNC();

    bf16_t* XS = (bf16_t*)(ws + W_XS); const float* GMp = (const float*)(ws + W_GM); float* RSp = (float*)(ws + W_RS); const float* NBp = (const float*)(ws + W_NB);
    bf16_t* ACT = (bf16_t*)(ws + W_R1);
    { pg8::Gemm g{(const bf16_t*)(ws + W_R1), (const bf16_t*)(ws + W_WOUT), T, 1024, 1024}; S.init(T, 1024, G, bx);
      pg8::EpiResGate E{Y, P.in[0], P.in[1] - (size_t)TC * 1024, MOD, 0 * 6 + 2, nullptr, XS, GMp, RSp};
      pg8::gemm_phase((LAS unsigned char*)lds, g, S, E); }
    GSYNC();
    { pg8::Gemm g{XS, (const bf16_t*)(ws + W_WGU), T, 5632, 1024}; S.init(T, 5632, G, bx);
      pg8::EpiGated<0> E{ACT, FFN, NBp, RSp};
      pg8::gemm_phase((LAS unsigned char*)lds, g, S, E); }
    GSYNC();
    { pg8::Gemm g{ACT, (const bf16_t*)(ws + W_WDN), T, 1024, FFN}; S.init(T, 1024, G, bx);
      pg8::EpiResGate E{Y, Y, Y, MOD, 0 * 6 + 5, nullptr, XS, GMp + 5120, RSp + T};
      pg8::gemm_phase((LAS unsigned char*)lds, g, S, E); }
    GSYNC();
    { pg8::Gemm g{XS, (const bf16_t*)(ws + W_WPW1), T, 2048, 1024}; S.init(T, 2048, G, bx);
      pg8::EpiGated<1> E{ACT, 1024, NBp + 5632, RSp + T};
      pg8::gemm_phase((LAS unsigned char*)lds, g, S, E); }
    GSYNC();
    dwconv_phase(P, lds);
    GSYNC();
    { pg8::Gemm g{ACT + (size_t)T * 1024, (const bf16_t*)(ws + W_WPW2), T, 1024, 1024}; S.init(T, 1024, G, bx);
      pg8::EpiResGate E{Y, Y, Y, MOD, 6 + 2, P.in[29], XS, GMp + 2 * 5120, RSp + 2 * T};
      pg8::gemm_phase((LAS unsigned char*)lds, g, S, E); }
    GSYNC();
    { pg8::Gemm g{XS, (const bf16_t*)(ws + W_WGU) + (size_t)5632 * 1024, T, 5632, 1024}; S.init(T, 5632, G, bx);
      pg8::EpiGated<0> E{ACT, FFN, NBp + 7680, RSp + 2 * T};
      pg8::gemm_phase((LAS unsigned char*)lds, g, S, E); }
    GSYNC();
    { pg8::Gemm g{ACT, (const bf16_t*)(ws + W_WDN) + (size_t)1024 * FFN, T, 1024, FFN}; S.init(T, 1024, G, bx);
      pg8::EpiResGate E{Y, Y, Y, MOD, 6 + 5, nullptr, nullptr, nullptr, nullptr};
      pg8::gemm_phase((LAS unsigned char*)lds, g, S, E); }
}

extern "C" void kernel_launch(void* const* d_in, const int* in_sizes, int n_in, void* d_out, int out_size, void* d_ws, size_t ws_size, hipStream_t stream) {
    static int grid_blocks = 0;
    if (!grid_blocks) {
        int dev = 0, cus = 0, per_cu = 0;
        hipGetDevice(&dev);
        hipDeviceGetAttribute(&cus, hipDeviceAttributeMultiprocessorCount, dev);
        hipFuncSetAttribute((const void*)fwd_megakernel, hipFuncAttributeMaxDynamicSharedMemorySize, LDS_BYTES);
        hipOccupancyMaxActiveBlocksPerMultiprocessor(&per_cu, (const void*)fwd_megakernel, 512, LDS_BYTES);
        if (per_cu < 1) { fprintf(stderr, "occupancy query: %d blocks per CU\n", per_cu); per_cu = 1; }
        if (per_cu > 1) per_cu = 1;
        grid_blocks = cus * per_cu;
        if (n_in != 33 || ws_size < W_END) fprintf(stderr, "unexpected n_in %d / ws_size %zu\n", n_in, ws_size);
    }
    Params p{};
    for (int i = 0; i < 33; ++i) p.in[i] = (const float*)d_in[i];
    p.out = (float*)d_out; p.ws = (unsigned char*)d_ws;
    (void)hipMemsetAsync((unsigned char*)d_ws + W_BAR, 0, XCD_BAR_WORDS * 4, stream);
    void* args[] = {&p};
    hipError_t e = hipLaunchCooperativeKernel((const void*)fwd_megakernel, dim3(grid_blocks), dim3(512), args, LDS_BYTES, stream);
    if (e != hipSuccess) fprintf(stderr, "cooperative launch failed: %s (grid %d)\n", hipGetErrorString(e), grid_blocks);
}
```

```cpp
#include <hip/hip_runtime.h>
#include <hip/hip_cooperative_groups.h>
#include <cstdio>
#include <cstdint>
namespace cg = cooperative_groups;

#define LAS __attribute__((address_space(3)))
typedef unsigned short bf16_t;
typedef short bf16x8 __attribute__((ext_vector_type(8)));
typedef short bf16x4 __attribute__((ext_vector_type(4)));
typedef float f32x4 __attribute__((ext_vector_type(4)));
typedef float f32x16 __attribute__((ext_vector_type(16)));
typedef unsigned u32x4 __attribute__((ext_vector_type(4)));
typedef unsigned u32x2 __attribute__((ext_vector_type(2)));

constexpr int D = 1024, TC = 8192, TS = 16384, T = TC + TS, TK = T + 1024;
constexpr int FFN = 2816, PA_LD = 640, PB_LD = 1664;
constexpr int PB_KROPE = 0, PB_GQ = 32, PB_GK = 288, PB_GV = 544, PB_GG = 1056, PB_GA = 1568;
constexpr int LKS = 4352;
constexpr float EPS = 1e-6f;
constexpr float QSCALE = 1.4426950408889634f * 0.10206207261596577f;

constexpr size_t W_WIN = 0;
constexpr size_t W_WUQ = W_WIN + (size_t)2304 * 1024 * 2;
constexpr size_t W_WUKV = W_WUQ + (size_t)768 * 384 * 2;
constexpr size_t W_WOUT = W_WUKV + (size_t)1024 * 256 * 2;
constexpr size_t W_WPW1 = W_WOUT + (size_t)1024 * 1024 * 2;
constexpr size_t W_WPW2 = W_WPW1 + (size_t)2048 * 1024 * 2;
constexpr size_t W_WGU = W_WPW2 + (size_t)1024 * 1024 * 2;
constexpr size_t W_WDN = W_WGU + (size_t)2 * 5632 * 1024 * 2;
constexpr size_t W_MOD = W_WDN + (size_t)2 * 1024 * 2816 * 2;
constexpr size_t W_ROPE = W_MOD + (size_t)5 * 2 * 6 * 1024 * 4;
constexpr size_t W_R1 = W_ROPE + (size_t)4096 * 16 * 8;
constexpr size_t W_R3 = W_R1 + (size_t)T * 1024 * 2;
constexpr size_t W_QRAW = W_R3;
constexpr size_t W_KVRAW = W_R3 + (size_t)T * 768 * 2;
constexpr size_t W_VTC = W_KVRAW + (size_t)TK * 1024 * 2;
constexpr size_t W_VTS = W_VTC + (size_t)32 * 8 * 64 * 256 * 2;
constexpr size_t W_DS = W_VTS + (size_t)4 * 8 * 64 * LKS * 2;
constexpr size_t W_END = W_DS + (size_t)1536 * 2 * 8192 * 2;
static_assert(W_END <= (size_t)256 * 1024 * 1024, "workspace");
static_assert(W_R3 + (size_t)T * FFN * 2 <= (size_t)256 * 1024 * 1024, "workspace (ACT)");
constexpr size_t W_CQN = W_R1;
constexpr size_t W_CKVN = W_R1 + (size_t)T * 384 * 2;
constexpr size_t W_BAR = W_END;
constexpr size_t W_RS = W_BAR + 16384;
constexpr size_t W_GM = W_RS + (size_t)5 * T * 4;
constexpr size_t W_NB = W_GM + (size_t)3 * 5 * 1024 * 4;
constexpr size_t W_AUX_END = W_NB + (size_t)5 * 13312 * 4;
static_assert(W_AUX_END <= (size_t)256 * 1024 * 1024, "aux buffers");
constexpr size_t W_CQ = W_DS, W_CKV = W_DS + (size_t)20 * 1024 * 1024;
constexpr size_t W_XS = W_R1 + (size_t)T * FFN * 2;
static_assert(W_XS + (size_t)T * 1024 * 2 <= W_END, "XS");
constexpr size_t O_CKV = (size_t)T * 1024, O_KROPE = O_CKV + (size_t)8192 * 256, O_STATE = O_KROPE + (size_t)8192 * 32;
constexpr size_t OS_PB = 0, OS_E = (size_t)T * PB_LD * 2;
static_assert(OS_E + (size_t)1536 * 2 * 64 * 4 <= (size_t)T * 1024 * 4, "d_out scratch");

struct Params { const float* in[33]; float* out; unsigned char* ws; };

__device__ __forceinline__ float bf2f(bf16_t v) { return __uint_as_float(((unsigned)v) << 16); }
__device__ __forceinline__ float bflo(unsigned u) { return __uint_as_float(u << 16); }
__device__ __forceinline__ float bfhi(unsigned u) { return __uint_as_float(u & 0xffff0000u); }
typedef __bf16 bf16v2_t __attribute__((ext_vector_type(2)));
typedef float f32x2_t __attribute__((ext_vector_type(2)));
__device__ __forceinline__ unsigned pk2(float lo, float hi) { const f32x2_t v = {lo, hi}; const bf16v2_t b = __builtin_convertvector(v, bf16v2_t); return __builtin_bit_cast(unsigned, b); }
__device__ __forceinline__ bf16_t f2bf(float f) { return (bf16_t)(pk2(f, 0.f) & 0xffffu); }
template <int CTRL> __device__ __forceinline__ float dpp_xadd(float v) { return v + __int_as_float(__builtin_amdgcn_update_dpp(0, __float_as_int(v), CTRL, 0xf, 0xf, true)); }
__device__ __forceinline__ float wave_sum(float v) {
    v = dpp_xadd<0xB1>(v);
    v = dpp_xadd<0x4E>(v);
    v = dpp_xadd<0x141>(v);
    v = dpp_xadd<0x140>(v);
    const int iv = __float_as_int(v);
    return __int_as_float(__builtin_amdgcn_readlane(iv, 0)) + __int_as_float(__builtin_amdgcn_readlane(iv, 16)) + __int_as_float(__builtin_amdgcn_readlane(iv, 32)) + __int_as_float(__builtin_amdgcn_readlane(iv, 48));
}
__device__ __forceinline__ float sigmoidf_(float x) { return __builtin_amdgcn_rcpf(1.f + __expf(-x)); }
__device__ __forceinline__ int tid_opaque() { int t = threadIdx.x; asm volatile("" : "+v"(t)); return t; }
__device__ __forceinline__ int row_group(int r) { return r < TC ? 0 : 1 + ((r - TC) >> 12); }

namespace pg8 {
constexpr int BM = 256, BK = 64, HALF = 128, HTB = HALF * BK * 2, STAGE_BYTES = 8 * HTB, NXCD = 8, WGM = 8;
__host__ __device__ __forceinline__ int lds_byte(int r, int c) { const int st = (r >> 4) * 2 + (c >> 5), rr = r & 15, cc = c & 31, ob = rr * 64 + cc * 2; return st * 1024 + (ob ^ (((ob >> 9) & 1) << 5)); }
__host__ __device__ __forceinline__ void stage_rc(int b, int& R, int& C) { const int st = b / 1024, sb = b % 1024, swz = sb ^ (((sb >> 9) & 1) << 5); R = (st >> 1) * 16 + swz / 64; C = (st & 1) * 32 + (swz % 64) / 2; }
__host__ __device__ __forceinline__ int perm32(int rho) { const int n = rho >> 4, i = rho & 15; return 8 * (i >> 2) + 4 * n + (i & 3); }
struct Unit { int pm, pn, half; };
struct Gemm { const bf16_t* A; const bf16_t* Bt; int M, N, K; };
struct StaticOrder {
    int nM, nN, nwg, G, c;
    int nFull;
    __device__ void init(int M, int N, int G_, int c_) { nM = M / BM; nN = N / BM; nwg = nM * nN; G = G_; c = c_; nFull = (nwg / G) * G; if (2 * (nwg - nFull) > G) nFull = nwg; }
    __device__ bool next(int i, Unit& u) const {
        const long L = (long)i * G + c; if (L >= nFull + 2 * (nwg - nFull)) return false;
        int wgid = (int)L; u.half = 0;
        if (wgid >= nFull) { const int hs = wgid - nFull; u.half = 1 + (hs & 1); wgid = nFull + (hs >> 1); } { const int q = nwg / NXCD, r = nwg % NXCD, xcd = wgid % NXCD, off = wgid / NXCD; wgid = (xcd < r ? xcd * (q + 1) : r * (q + 1) + (xcd - r) * q) + off; }
        const int nig = WGM * nN, gid = wgid / nig, fm = gid * WGM, gsz = (nM - fm) < WGM ? (nM - fm) : WGM;
        u.pm = fm + ((wgid % nig) % gsz); u.pn = (wgid % nig) / gsz; return true;
    }
};

template <class Epi>
__device__ __forceinline__ void gemm_phase(LAS unsigned char* lds, const Gemm g, const StaticOrder& S, const Epi& E) {
    const int tid = tid_opaque(), wid = __builtin_amdgcn_readfirstlane(tid >> 6), lane = tid & 63, wr = wid >> 2, wc = wid & 3, fr = lane & 15, fq = lane >> 4;
    const int K = g.K, nt = K / BK;
    unsigned voffA[2], voffB[2];
#pragma unroll
    for (int i = 0; i < 2; ++i) { int R, C; stage_rc(tid * 16 + i * 8192, R, C); const int Rb = Epi::PERM ? ((R & ~31) + perm32(R & 31)) : R;
        voffA[i] = (unsigned)(R * K + C) * 2u; voffB[i] = (unsigned)(Rb * K + C) * 2u; }
    const size_t kstep = (size_t)(BK * 2);
    const size_t hstep = (size_t)HALF * K * 2;
    const size_t tstep = 2 * hstep;
    const unsigned ldsw = (unsigned)wid * 1024u;
    const int aoff = lds_byte(wr * 64 + fr, fq * 8), boff = lds_byte(wc * 32 + fr, fq * 8);
#define PG8_SA(b, h) (((b) * 2 + (h)) * HTB)
#define PG8_SB(b, h) ((4 + (b) * 2 + (h)) * HTB)
#define PG8_STAGE(bufoff, gbase, voff) do { _Pragma("unroll") for (int _i = 0; _i < 2; ++_i) \
        __builtin_amdgcn_global_load_lds((const unsigned*)((const char*)(gbase) + (voff)[_i]), (LAS unsigned*)(lds + (bufoff) + ldsw + _i * 8192), 16, 0, 0); } while (0)
#define PG8_LDA(dst, b, h) do { _Pragma("unroll") for (int m = 0; m < 4; ++m) _Pragma("unroll") for (int k = 0; k < 2; ++k) dst[m][k] = *(const LAS bf16x8*)(lds + PG8_SA(b, h) + aoff + m * 2048 + k * 1024); } while (0)
#define PG8_LDB(dst, b, h) do { _Pragma("unroll") for (int n = 0; n < 2; ++n) _Pragma("unroll") for (int k = 0; k < 2; ++k) dst[n][k] = *(const LAS bf16x8*)(lds + PG8_SB(b, h) + boff + n * 2048 + k * 1024); } while (0)
#define PG8_MMA(ai, bj, At, Bt) do { __builtin_amdgcn_s_setprio(1); _Pragma("unroll") for (int m = 0; m < 4; ++m) _Pragma("unroll") for (int n = 0; n < 2; ++n) _Pragma("unroll") for (int k = 0; k < 2; ++k) \
        acc[ai][bj][m][n] = __builtin_amdgcn_mfma_f32_16x16x32_bf16(Bt[n][k], At[m][k], acc[ai][bj][m][n], 0, 0, 0); __builtin_amdgcn_s_setprio(0); } while (0)
#define PG8_WAIT_V(n) asm volatile("s_waitcnt vmcnt(" #n ")" ::: "memory")
#define PG8_WAIT_L(n) asm volatile("s_waitcnt lgkmcnt(" #n ")" ::: "memory")
#define PG8_BAR __builtin_amdgcn_s_barrier()
#define PG8_SCHED __builtin_amdgcn_sched_barrier(0)
    Unit cur, nxt; int ui = 0;
    if (!S.next(0, cur)) return;
    f32x4 acc[2][2][4][2];
#pragma unroll
    for (int a = 0; a < 2; ++a)
#pragma unroll
        for (int b = 0; b < 2; ++b)
#pragma unroll
            for (int m = 0; m < 4; ++m)
#pragma unroll
                for (int n = 0; n < 2; ++n) acc[a][b][m][n] = (f32x4){0.f, 0.f, 0.f, 0.f};
    bf16x8 At[4][2], B0[2][2], B1[2][2];
    const char* cA = (const char*)g.A + (size_t)cur.pm * tstep + (cur.half == 2 ? hstep : (size_t)0); const char* cB = (const char*)g.Bt + (size_t)cur.pn * tstep;
    PG8_STAGE(PG8_SB(0, 0), cB, voffB); PG8_STAGE(PG8_SA(0, 0), cA, voffA); PG8_STAGE(PG8_SB(0, 1), cB + hstep, voffB); PG8_STAGE(PG8_SA(0, 1), cA + hstep, voffA);
    if (wr == 1) PG8_BAR;
    PG8_WAIT_V(4); PG8_BAR;
    PG8_STAGE(PG8_SB(1, 0), cB + kstep, voffB); PG8_STAGE(PG8_SA(1, 0), cA + kstep, voffA); PG8_STAGE(PG8_SB(1, 1), cB + hstep + kstep, voffB);
    PG8_WAIT_V(6); PG8_BAR;
    for (;;) {
        const bool has_next = S.next(ui + 1, nxt);
        const char* nA = has_next ? (const char*)g.A + (size_t)nxt.pm * tstep + (nxt.half == 2 ? hstep : (size_t)0) : cA; const bool whole = (cur.half == 0); const char* nB = has_next ? (const char*)g.Bt + (size_t)nxt.pn * tstep : cB;
        for (int t = 0; t < nt; t += 2) {
            const bool last = (t == nt - 2);
            const char* a1 = cA + (size_t)(t + 1) * kstep;
            const char* a2 = last ? nA : cA + (size_t)(t + 2) * kstep; const char* b2 = last ? nB : cB + (size_t)(t + 2) * kstep;
            const char* a3 = a2 + kstep; const char* b3 = b2 + kstep;
            PG8_LDB(B0, 0, 0); PG8_SCHED; PG8_LDA(At, 0, 0); PG8_STAGE(PG8_SA(1, 1), a1 + hstep, voffA);
            PG8_WAIT_L(8); PG8_BAR; PG8_WAIT_L(0); PG8_MMA(0, 0, At, B0); PG8_BAR; PG8_SCHED;
            PG8_LDB(B1, 0, 1); PG8_STAGE(PG8_SB(0, 0), b2, voffB);
            PG8_BAR; PG8_WAIT_L(0); PG8_MMA(0, 1, At, B1); PG8_BAR;
            if (whole) PG8_LDA(At, 0, 1); PG8_STAGE(PG8_SA(0, 0), a2, voffA);
            PG8_BAR; PG8_WAIT_L(0); if (whole) PG8_MMA(1, 0, At, B0); PG8_BAR; PG8_SCHED;
            PG8_STAGE(PG8_SB(0, 1), b2 + hstep, voffB);
            PG8_WAIT_V(6); PG8_BAR; if (whole) PG8_MMA(1, 1, At, B1); PG8_BAR;
            PG8_LDB(B0, 1, 0); PG8_SCHED; PG8_LDA(At, 1, 0); PG8_STAGE(PG8_SA(0, 1), a2 + hstep, voffA);
            PG8_WAIT_L(8); PG8_BAR; PG8_WAIT_L(0); PG8_MMA(0, 0, At, B0); PG8_BAR; PG8_SCHED;
            PG8_LDB(B1, 1, 1); PG8_STAGE(PG8_SB(1, 0), b3, voffB);
            PG8_BAR; PG8_WAIT_L(0); PG8_MMA(0, 1, At, B1); PG8_BAR;
            if (whole) PG8_LDA(At, 1, 1); PG8_STAGE(PG8_SA(1, 0), a3, voffA);
            PG8_BAR; PG8_WAIT_L(0); if (whole) PG8_MMA(1, 0, At, B0); PG8_BAR; PG8_SCHED;
            PG8_STAGE(PG8_SB(1, 1), b3 + hstep, voffB);
            PG8_WAIT_V(6); PG8_BAR; if (whole) PG8_MMA(1, 1, At, B1); PG8_BAR;
        }
        E(acc, cur, wr, wc, fr, fq);
        if (!has_next) break;
#pragma unroll
        for (int a = 0; a < 2; ++a)
#pragma unroll
            for (int b = 0; b < 2; ++b)
#pragma unroll
                for (int m = 0; m < 4; ++m)
#pragma unroll
                    for (int n = 0; n < 2; ++n) acc[a][b][m][n] = (f32x4){0.f, 0.f, 0.f, 0.f};
        cur = nxt; cA = nA; cB = nB; ++ui;
    }
    PG8_WAIT_V(0);
    if (wr == 0) PG8_BAR;
    PG8_BAR;
#undef PG8_SA
#undef PG8_SB
#undef PG8_STAGE
#undef PG8_LDA
#undef PG8_LDB
#undef PG8_MMA
#undef PG8_WAIT_V
#undef PG8_WAIT_L
#undef PG8_BAR
#undef PG8_SCHED
}

typedef const f32x4 (&AccRef)[2][2][4][2];

struct EpiBf16Split {
    static constexpr bool PERM = true;
    bf16_t* O0; int ld0; bf16_t* O1; int ld1; int split;
    __device__ __forceinline__ void operator()(AccRef acc, const Unit& u, int wr, int wc, int fr, int fq) const {
        const int row0 = u.pm * BM + wr * 64 + fr + (u.half == 2 ? HALF : 0); const int nai = u.half ? 1 : 2;
#pragma unroll
        for (int bj = 0; bj < 2; ++bj) {
            const int cb = u.pn * BM + bj * HALF; bf16_t* base; int ld, c;
            if (cb < split) { base = O0; ld = ld0; c = cb; } else { base = O1; ld = ld1; c = cb - split; }
            c += wc * 32 + 8 * fq;
#pragma unroll
            for (int ai = 0; ai < 2; ++ai) if (ai < nai)
#pragma unroll
                for (int m = 0; m < 4; ++m) {
                    const f32x4 v0 = acc[ai][bj][m][0], v1 = acc[ai][bj][m][1];
                    u32x4 o = {pk2(v0[0], v0[1]), pk2(v0[2], v0[3]), pk2(v1[0], v1[1]), pk2(v1[2], v1[3])};
                    *(u32x4*)(base + (size_t)(row0 + ai * HALF + m * 16) * ld + c) = o;
                    __builtin_amdgcn_sched_barrier(0);
                }
        }
    }
};
struct EpiProj {
    static constexpr bool PERM = true;
    bf16_t* CQ; bf16_t* CKV; bf16_t* O1; int ld1; float* rsq; float* rskv;
    __device__ __forceinline__ void operator()(AccRef acc, const Unit& u, int wr, int wc, int fr, int fq) const {
        const int row0 = u.pm * BM + wr * 64 + fr + (u.half == 2 ? HALF : 0); const int nai = u.half ? 1 : 2;
#pragma unroll
        for (int bj = 0; bj < 2; ++bj) {
            const int cb = u.pn * BM + bj * HALF; bf16_t* base; int ld, c; float* rs;
            if (cb < 384) { base = CQ; ld = 384; c = cb; rs = rsq; } else if (cb < 640) { base = CKV; ld = 256; c = cb - 384; rs = rskv; } else { base = O1; ld = ld1; c = cb - 640; rs = nullptr; }
            c += wc * 32 + 8 * fq;
#pragma unroll
            for (int ai = 0; ai < 2; ++ai) if (ai < nai)
#pragma unroll
                for (int m = 0; m < 4; ++m) {
                    const f32x4 v0 = acc[ai][bj][m][0], v1 = acc[ai][bj][m][1];
                    u32x4 o = {pk2(v0[0], v0[1]), pk2(v0[2], v0[3]), pk2(v1[0], v1[1]), pk2(v1[2], v1[3])};
                    *(u32x4*)(base + (size_t)(row0 + ai * HALF + m * 16) * ld + c) = o;
                    if (rs) { float q = v0[0] * v0[0] + v0[1] * v0[1] + v0[2] * v0[2] + v0[3] * v0[3] + v1[0] * v1[0] + v1[1] * v1[1] + v1[2] * v1[2] + v1[3] * v1[3];
                        q += __shfl_xor(q, 16); q += __shfl_xor(q, 32);
                        if (fq == 0) (void)__hip_atomic_fetch_add(rs + row0 + ai * HALF + m * 16, q, __ATOMIC_RELAXED, __HIP_MEMORY_SCOPE_AGENT); }
                    __builtin_amdgcn_sched_barrier(0);
                }
        }
    }
};
struct EpiBf16Scaled {
    static constexpr bool PERM = true;
    bf16_t* O; int ld; const float* rowss; float inv_k; int nscaled;
    __device__ __forceinline__ void operator()(AccRef acc, const Unit& u, int wr, int wc, int fr, int fq) const {
        const int row0 = u.pm * BM + wr * 64 + fr + (u.half == 2 ? HALF : 0); const int nai = u.half ? 1 : 2;
        float rs[2][4];
#pragma unroll
        for (int ai = 0; ai < 2; ++ai)
#pragma unroll
            for (int m = 0; m < 4; ++m) { const int r = row0 + (ai < nai ? ai : 0) * HALF + m * 16; rs[ai][m] = (r < nscaled) ? rowss[r] : -1.f; }
#pragma unroll
        for (int ai = 0; ai < 2; ++ai) if (ai < nai)
#pragma unroll
            for (int m = 0; m < 4; ++m) { const float rinv = rs[ai][m] >= 0.f ? rsqrtf(rs[ai][m] * inv_k + EPS) : 1.f;
#pragma unroll
                for (int bj = 0; bj < 2; ++bj) {
                    const f32x4 v0 = acc[ai][bj][m][0] * rinv, v1 = acc[ai][bj][m][1] * rinv;
                    u32x4 o = {pk2(v0[0], v0[1]), pk2(v0[2], v0[3]), pk2(v1[0], v1[1]), pk2(v1[2], v1[3])};
                    *(u32x4*)(O + (size_t)(row0 + ai * HALF + m * 16) * ld + u.pn * BM + bj * HALF + wc * 32 + 8 * fq) = o; }
                __builtin_amdgcn_sched_barrier(0); }
    }
};
struct EpiResGate {
    static constexpr bool PERM = false;
    float* out; const float* resA; const float* resB; const float* mod; int gate_idx; const float* bias;
    bf16_t* xs; const float* gm; float* rowss;
    __device__ __forceinline__ void operator()(AccRef acc, const Unit& u, int wr, int wc, int fr, int fq) const {
        const int row0 = u.pm * BM + wr * 64 + fr + (u.half == 2 ? HALF : 0), col0 = u.pn * BM + wc * 32 + 4 * fq; const int nai = u.half ? 1 : 2;
        const int g = row_group(u.pm * BM);
        const float* res = (u.pm * BM < TC) ? resA : resB;
        const float* gp = mod + (size_t)(g * 12 + gate_idx) * 1024;
        f32x4 gv[2][2], gmv[2][2], bv[2][2];
#pragma unroll
        for (int bj = 0; bj < 2; ++bj)
#pragma unroll
            for (int n = 0; n < 2; ++n) { const int cc = col0 + bj * HALF + n * 16;
                gv[bj][n] = *(const f32x4*)(gp + cc);
                gmv[bj][n] = xs ? *(const f32x4*)(gm + (size_t)g * 1024 + cc) : (f32x4){0.f, 0.f, 0.f, 0.f};
                bv[bj][n] = bias ? *(const f32x4*)(bias + cc) : (f32x4){0.f, 0.f, 0.f, 0.f}; }
        const int nrow = nai * 4;
        f32x4 rcur[2][2], rnxt[2][2];
#pragma unroll
        for (int bj = 0; bj < 2; ++bj)
#pragma unroll
            for (int n = 0; n < 2; ++n) rcur[bj][n] = *(const f32x4*)(res + (size_t)row0 * 1024 + col0 + bj * HALF + n * 16);
#pragma unroll
        for (int it = 0; it < 8; ++it) if (it < nrow) {
            const int ai = it >> 2, m = it & 3;
            const size_t ro = (size_t)(row0 + ai * HALF + m * 16) * 1024 + col0; float ssq = 0.f;
            if (it + 1 < nrow) { const size_t rn = (size_t)(row0 + ((it + 1) >> 2) * HALF + ((it + 1) & 3) * 16) * 1024 + col0;
#pragma unroll
                for (int bj = 0; bj < 2; ++bj)
#pragma unroll
                    for (int n = 0; n < 2; ++n) rnxt[bj][n] = *(const f32x4*)(res + rn + bj * HALF + n * 16); }
#pragma unroll
            for (int bj = 0; bj < 2; ++bj)
#pragma unroll
                for (int n = 0; n < 2; ++n) {
                    const f32x4 o = rcur[bj][n] + gv[bj][n] * (acc[ai][bj][m][n] + bv[bj][n]);
                    *(f32x4*)(out + ro + bj * HALF + n * 16) = o;
                    if (xs) { const f32x4 y = o * gmv[bj][n];
                        *(u32x2*)(xs + ro + bj * HALF + n * 16) = (u32x2){pk2(y[0], y[1]), pk2(y[2], y[3])};
                        ssq += o[0] * o[0] + o[1] * o[1] + o[2] * o[2] + o[3] * o[3]; } }
            if (xs) { ssq += __shfl_xor(ssq, 16); ssq += __shfl_xor(ssq, 32);
                if (fq == 0) (void)__hip_atomic_fetch_add(rowss + row0 + ai * HALF + m * 16, ssq, __ATOMIC_RELAXED, __HIP_MEMORY_SCOPE_AGENT); }
#pragma unroll
            for (int bj = 0; bj < 2; ++bj)
#pragma unroll
                for (int n = 0; n < 2; ++n) rcur[bj][n] = rnxt[bj][n];
            __builtin_amdgcn_sched_barrier(0); }
    }
};
template <int MODE> struct EpiGated {
    static constexpr bool PERM = true;
    bf16_t* O; int ldo; const float* nb; const float* rowss;
    __device__ __forceinline__ void operator()(AccRef acc, const Unit& u, int wr, int wc, int fr, int fq) const {
        const int row0 = u.pm * BM + wr * 64 + fr + (u.half == 2 ? HALF : 0), c = u.pn * HALF + wc * 32 + 8 * fq; const int nai = u.half ? 1 : 2;
        const float* nbp = nb + (size_t)row_group(u.pm * BM) * 13312 + u.pn * 256 + wc * 32 + 8 * fq;
        f32x4 ba[2], bb[2];
#pragma unroll
        for (int n = 0; n < 2; ++n) { ba[n] = *(const f32x4*)(nbp + 4 * n); bb[n] = *(const f32x4*)(nbp + 128 + 4 * n); }
        float rs[2][4];
#pragma unroll
        for (int ai = 0; ai < 2; ++ai)
#pragma unroll
            for (int m = 0; m < 4; ++m) rs[ai][m] = rowss[row0 + (ai < nai ? ai : 0) * HALF + m * 16];
#pragma unroll
        for (int ai = 0; ai < 2; ++ai) if (ai < nai)
#pragma unroll
            for (int m = 0; m < 4; ++m) {
                float r[8];
                const float rinv = rsqrtf(rs[ai][m] * (1.f / 1024.f) + EPS);
                const f32x2_t rinv2 = {rinv, rinv};
#pragma unroll
                for (int n = 0; n < 2; ++n)
#pragma unroll
                    for (int e = 0; e < 4; e += 2) {
                        const f32x2_t a = __builtin_elementwise_fma((f32x2_t){acc[ai][0][m][n][e], acc[ai][0][m][n][e + 1]}, rinv2, (f32x2_t){ba[n][e], ba[n][e + 1]});
                        const f32x2_t b = __builtin_elementwise_fma((f32x2_t){acc[ai][1][m][n][e], acc[ai][1][m][n][e + 1]}, rinv2, (f32x2_t){bb[n][e], bb[n][e + 1]});
                        const f32x2_t z = ((MODE == 0) ? a : b) * (f32x2_t){-1.4426950408889634f, -1.4426950408889634f};
                        const f32x2_t den = (f32x2_t){__builtin_amdgcn_exp2f(z[0]), __builtin_amdgcn_exp2f(z[1])} + (f32x2_t){1.f, 1.f};
                        const f32x2_t sg = {__builtin_amdgcn_rcpf(den[0]), __builtin_amdgcn_rcpf(den[1])};
                        const f32x2_t o2 = (MODE == 0) ? (a * sg) * b : a * sg;
                        r[n * 4 + e] = o2[0]; r[n * 4 + e + 1] = o2[1]; }
                u32x4 o = {pk2(r[0], r[1]), pk2(r[2], r[3]), pk2(r[4], r[5]), pk2(r[6], r[7])};
                *(u32x4*)(O + (size_t)(row0 + ai * HALF + m * 16) * ldo + c) = o;
                if (m & 1) __builtin_amdgcn_sched_barrier(0);
            }
    }
};
}

__device__ __forceinline__ void conv_tile(const float* __restrict__ W, int K, int N, bf16_t* __restrict__ Wt, int kt, int ntile, int map, int half_n, float* sm) {
    const int t = tid_opaque(), k0 = kt * 64, n0 = ntile * 64;
#pragma unroll
    for (int i = 0; i < 8; ++i) { const int idx = i * 512 + t, kk = idx >> 6, nn = idx & 63; sm[kk * 65 + nn] = W[(size_t)(k0 + kk) * N + n0 + nn]; }
    __syncthreads();
    const int nn = t >> 3, ks = (t & 7) * 8;
    float v[8];
#pragma unroll
    for (int j = 0; j < 8; ++j) v[j] = sm[(ks + j) * 65 + nn];
    int n = n0 + nn, dst;
    if (map == 0) dst = n;
    else { int up = 0; if (n >= half_n) { n -= half_n; up = 128; } dst = (n >> 7) * 256 + (n & 127) + up; }
    u32x4 o = {pk2(v[0], v[1]), pk2(v[2], v[3]), pk2(v[4], v[5]), pk2(v[6], v[7])};
    *(u32x4*)(Wt + (size_t)dst * K + k0 + ks) = o;
    __syncthreads();
}

__device__ __forceinline__ void p0_prologue(const Params& P, unsigned char* smraw) {
    float* sm = (float*)smraw;
    unsigned char* ws = P.ws;
    const int t = tid_opaque();
    constexpr int N_ADA = 256, N_ZERO = 1, N_ROPE = 16, N_CONV = 0;
    constexpr int I_ZERO = N_ADA, I_ROPE = I_ZERO + N_ZERO, I_CONV = I_ROPE + N_ROPE, N_ITEMS = I_CONV + N_CONV;
    for (int it = blockIdx.x; it < N_ITEMS; it += gridDim.x) {
        if (it < N_ADA) {
            const int layer = it >> 7, cch = it & 127;
            float* sc = sm;
            float* red = sm + 5 * 1024;
            for (int i = t; i < 5 * 1024; i += 512) { const int g = i >> 10, k = i & 1023; const float c = (g == 0) ? P.in[6][k] : P.in[5][(g - 1) * 1024 + k]; sc[i] = c * sigmoidf_(c); }
            __syncthreads();
            if (t < 384) {
                const int cg4 = t % 12, kg = t / 12;
                const float* w = P.in[7] + (size_t)layer * 1024 * 6144 + (size_t)(kg * 32) * 6144 + cch * 48 + cg4 * 4;
                f32x4 a[5];
#pragma unroll
                for (int g = 0; g < 5; ++g) a[g] = (f32x4){0.f, 0.f, 0.f, 0.f};
#pragma unroll 16
                for (int kk = 0; kk < 32; ++kk) { const f32x4 w4 = *(const f32x4*)(w + (size_t)kk * 6144);
#pragma unroll
                    for (int g = 0; g < 5; ++g) a[g] += w4 * sc[g * 1024 + kg * 32 + kk]; }
#pragma unroll
                for (int g = 0; g < 5; ++g) *(f32x4*)(red + (kg * 5 + g) * 48 + cg4 * 4) = a[g];
            }
            __syncthreads();
            if (t < 240) { const int g = t / 48, c = t % 48; float s_ = 0.f;
#pragma unroll 8
                for (int k2 = 0; k2 < 32; ++k2) s_ += red[(k2 * 5 + g) * 48 + c];
                const int col = cch * 48 + c;
                ((float*)(ws + W_MOD))[(size_t)(g * 2 + layer) * 6144 + col] = s_ + P.in[8][layer * 6144 + col]; }
            __syncthreads();
        } else if (it < I_ROPE) {
            u32x4* z = (u32x4*)(ws + W_WIN + (size_t)2240 * 1024 * 2);
            for (int i = t; i < 64 * 1024 * 2 / 16; i += 512) z[i] = (u32x4){0u, 0u, 0u, 0u};
        } else if (it < I_CONV) {
            const int base = (it - I_ROPE) * 4096;
            float2* rp = (float2*)(ws + W_ROPE);
            for (int i = t; i < 4096; i += 512) { const int e = base + i, l = e >> 4, f = e & 15, ax = f >> 3, fi = f & 7;
                const float pos = (float)(ax == 0 ? (l >> 6) : (l & 63));
                const float invf = powf(10000.f, -(float)(2 * fi) / 16.f);
                float s, c; sincosf(pos * invf, &s, &c); rp[e] = make_float2(c, s); }
        }
    }
    struct Job { const float* W; bf16_t* Wt; const float* ksc; int K, N, map, half, k0, n0; };
#define P0_DECODE(tile_, J) do { int tl = (tile_); (J).map = 0; (J).half = 1 << 30; (J).ksc = nullptr; \
        if (tl < 560) { (J).W = P.in[11]; (J).K = 1024; (J).N = 2240; (J).Wt = (bf16_t*)(ws + W_WIN); } \
        else if ((tl -= 560) < 72) { (J).W = P.in[13]; (J).K = 384; (J).N = 768; (J).Wt = (bf16_t*)(ws + W_WUQ); (J).ksc = P.in[12]; } \
        else if ((tl -= 72) < 64) { (J).W = P.in[15]; (J).K = 256; (J).N = 1024; (J).Wt = (bf16_t*)(ws + W_WUKV); (J).ksc = P.in[14]; } \
        else if ((tl -= 64) < 256) { (J).W = P.in[21]; (J).K = 1024; (J).N = 1024; (J).Wt = (bf16_t*)(ws + W_WOUT); } \
        else if ((tl -= 256) < 512) { (J).W = P.in[22]; (J).K = 1024; (J).N = 2048; (J).Wt = (bf16_t*)(ws + W_WPW1); (J).map = 1; (J).half = 1024; } \
        else if ((tl -= 512) < 256) { (J).W = P.in[28]; (J).K = 1024; (J).N = 1024; (J).Wt = (bf16_t*)(ws + W_WPW2); } \
        else if ((tl -= 256) < 1408) { const int l = tl / 704; tl -= l * 704; (J).W = P.in[30] + (size_t)l * 1024 * FFN; (J).K = 1024; (J).N = FFN; (J).Wt = (bf16_t*)(ws + W_WGU) + (size_t)l * 5632 * 1024; (J).map = 1; } \
        else if ((tl -= 1408) < 1408) { const int l = tl / 704; tl -= l * 704; (J).W = P.in[31] + (size_t)l * 1024 * FFN; (J).K = 1024; (J).N = FFN; (J).Wt = (bf16_t*)(ws + W_WGU) + (size_t)l * 5632 * 1024 + (size_t)128 * 1024; (J).map = 1; } \
        else { tl -= 1408; const int l = tl / 704; tl -= l * 704; (J).W = P.in[32] + (size_t)l * FFN * 1024; (J).K = FFN; (J).N = 1024; (J).Wt = (bf16_t*)(ws + W_WDN) + (size_t)l * 1024 * FFN; } \
        const int nN_ = (J).N / 64; (J).k0 = (tl / nN_) * 64; (J).n0 = (tl % nN_) * 64; } while (0)
#define P0_LOAD(J, v) do { _Pragma("unroll") for (int i_ = 0; i_ < 8; ++i_) { const int idx_ = i_ * 512 + t; v[i_] = (J).W[(size_t)((J).k0 + (idx_ >> 6)) * (J).N + (J).n0 + (idx_ & 63)]; } } while (0)
    {
        Job J, Jn; float v[8];
        int tile = blockIdx.x;
        if (tile < 5944) { P0_DECODE(tile, J); P0_LOAD(J, v); }
        for (; tile < 5944; tile += gridDim.x) {
#pragma unroll
            for (int i = 0; i < 8; ++i) { const int idx = i * 512 + t; sm[(idx >> 6) * 65 + (idx & 63)] = J.ksc ? v[i] * J.ksc[J.k0 + (idx >> 6)] : v[i]; }
            __syncthreads();
            const int nt_ = tile + (int)gridDim.x;
            if (nt_ < 5944) { P0_DECODE(nt_, Jn); P0_LOAD(Jn, v); }
            const int nn = t >> 3, ks = (t & 7) * 8;
            float x[8];
#pragma unroll
            for (int j = 0; j < 8; ++j) x[j] = sm[(ks + j) * 65 + nn];
            int n = J.n0 + nn, dst;
            if (J.map == 0) dst = n;
            else { int up = 0; if (n >= J.half) { n -= J.half; up = 128; } dst = (n >> 7) * 256 + (n & 127) + up; }
            *(u32x4*)(J.Wt + (size_t)dst * J.K + J.k0 + ks) = (u32x4){pk2(x[0], x[1]), pk2(x[2], x[3]), pk2(x[4], x[5]), pk2(x[6], x[7])};
            __syncthreads();
            J = Jn;
        }
    }
#undef P0_DECODE
#undef P0_LOAD
}

__device__ __forceinline__ void norm_phase(const float* xa, const float* xb, const float* gain, const float* mod, int mod_idx, bf16_t* H) {
    const int t_ = tid_opaque(), wave = t_ >> 6, lane = t_ & 63;
    for (int r = blockIdx.x * 8 + wave; r < T; r += gridDim.x * 8) {
        const float* x = (r < TC ? xa : xb) + (size_t)r * 1024;
        const float* sh = mod + (size_t)(row_group(r) * 12 + mod_idx) * 1024; const float* sc = sh + 1024;
        f32x4 v[4]; float ss = 0.f;
#pragma unroll
        for (int i = 0; i < 4; ++i) { v[i] = ((const f32x4*)x)[lane + 64 * i]; ss += v[i][0] * v[i][0] + v[i][1] * v[i][1] + v[i][2] * v[i][2] + v[i][3] * v[i][3]; }
        ss = wave_sum(ss);
        const float rinv = rsqrtf(ss * (1.f / 1024.f) + EPS);
#pragma unroll
        for (int i = 0; i < 4; ++i) { const int c = 4 * (lane + 64 * i);
            const f32x4 g4 = *(const f32x4*)(gain + c), s4 = *(const f32x4*)(sc + c), h4 = *(const f32x4*)(sh + c);
            const f32x4 y = v[i] * rinv * g4 * (s4 + 1.f) + h4;
            *(u32x2*)(H + (size_t)r * 1024 + c) = (u32x2){pk2(y[0], y[1]), pk2(y[2], y[3])}; }
    }
}

__device__ __forceinline__ void p1_aux(const Params& P) {
    unsigned char* ws = P.ws;
    const float* MOD = (const float*)(ws + W_MOD);
    const int t = tid_opaque(), wave = t >> 6, lane = t & 63;
    float* RS = (float*)(ws + W_RS);
    for (int i = blockIdx.x * 512 + t; i < 5 * T; i += gridDim.x * 512) RS[i] = 0.f;
    { bf16_t* CKV = (bf16_t*)(ws + W_CKV) + (size_t)T * 256;
      for (int i = blockIdx.x * 512 + t; i < 1024 * 256 / 4; i += gridDim.x * 512) { const f32x4 v = ((const f32x4*)P.in[2])[i], k4 = *(const f32x4*)(P.in[14] + ((i * 4) & 255));
          *(u32x2*)(CKV + (size_t)i * 4) = (u32x2){pk2(v[0] / k4[0], v[1] / k4[1]), pk2(v[2] / k4[2], v[3] / k4[3])}; } }
    float* GM = (float*)(ws + W_GM);
    for (int i = blockIdx.x * 512 + t; i < 3 * 5 * 1024; i += gridDim.x * 512) { const int j = i / 5120, g = (i % 5120) >> 10, c = i & 1023;
        const float gain = (j == 0) ? P.in[10][c] : (j == 1) ? P.in[9][1024 + c] : P.in[10][1024 + c];
        const int sci = (j == 0) ? 4 : (j == 1) ? 7 : 10;
        GM[i] = gain * (1.f + MOD[(size_t)(g * 12 + sci) * 1024 + c]); }
    float* NB = (float*)(ws + W_NB);
    for (int row = blockIdx.x * 8 + wave; row < 13312; row += gridDim.x * 8) {
        const bf16_t* wt; int shi; float extra = 0.f;
        if (row < 5632) { wt = (const bf16_t*)(ws + W_WGU) + (size_t)row * 1024; shi = 3; }
        else if (row < 7680) { const int n = row - 5632, w = n & 255; wt = (const bf16_t*)(ws + W_WPW1) + (size_t)n * 1024; shi = 6; extra = P.in[23][(n >> 8) * 128 + (w & 127) + (w >= 128 ? 1024 : 0)]; }
        else { wt = (const bf16_t*)(ws + W_WGU) + (size_t)5632 * 1024 + (size_t)(row - 7680) * 1024; shi = 9; }
        const u32x4 w0 = *(const u32x4*)(wt + lane * 16), w1 = *(const u32x4*)(wt + lane * 16 + 8);
        float wf[16];
#pragma unroll
        for (int e = 0; e < 4; ++e) { wf[2 * e] = bflo(w0[e]); wf[2 * e + 1] = bfhi(w0[e]); wf[8 + 2 * e] = bflo(w1[e]); wf[8 + 2 * e + 1] = bfhi(w1[e]); }
#pragma unroll
        for (int g = 0; g < 5; ++g) { const float* sh = MOD + (size_t)(g * 12 + shi) * 1024 + lane * 16; float a = 0.f;
#pragma unroll
            for (int q = 0; q < 4; ++q) { const f32x4 v = *(const f32x4*)(sh + 4 * q); a += v[0] * wf[4 * q] + v[1] * wf[4 * q + 1] + v[2] * wf[4 * q + 2] + v[3] * wf[4 * q + 3]; }
            a = wave_sum(a);
            if (lane == 0) NB[(size_t)g * 13312 + row] = a + extra; }
    }
}

__device__ __forceinline__ void p3_postproj(const Params& P) {
    unsigned char* ws = P.ws;
    const bf16_t* PA = (const bf16_t*)(ws + W_R3); const bf16_t* PB = (const bf16_t*)((unsigned char*)P.out + OS_PB);
    bf16_t* CQN = (bf16_t*)(ws + W_CQN); bf16_t* CKVN = (bf16_t*)(ws + W_CKVN);
    const float* qa = P.in[12]; const float* kva = P.in[14];
    const int t_ = tid_opaque(), wave = t_ >> 6, lane = t_ & 63;
    constexpr int RW = 4;
    float qg[6]; { for (int i = 0; i < 3; ++i) { qg[2 * i] = qa[2 * lane + 128 * i]; qg[2 * i + 1] = qa[2 * lane + 128 * i + 1]; } }
    const f32x4 g4 = *(const f32x4*)(kva + 4 * lane);
    for (int r0 = (blockIdx.x * 8 + wave) * RW; r0 < T; r0 += gridDim.x * 8 * RW) {
        unsigned q[RW][3]; u32x2 kv[RW]; unsigned short kr[RW];
#pragma unroll
        for (int j = 0; j < RW; ++j) { const bf16_t* pa = PA + (size_t)(r0 + j) * PA_LD;
#pragma unroll
            for (int i = 0; i < 3; ++i) q[j][i] = *(const unsigned*)(pa + 2 * lane + 128 * i);
            kv[j] = *(const u32x2*)(pa + 384 + 4 * lane);
            kr[j] = (r0 < TC && lane < 32) ? PB[(size_t)(r0 + j) * PB_LD + PB_KROPE + lane] : (unsigned short)0; }
#pragma unroll
        for (int j = 0; j < RW; ++j) { const int r = r0 + j;
            float ss = 0.f;
#pragma unroll
            for (int i = 0; i < 3; ++i) { const float a = bflo(q[j][i]), b = bfhi(q[j][i]); ss += a * a + b * b; }
            const float k0 = bflo(kv[j][0]), k1 = bfhi(kv[j][0]), k2 = bflo(kv[j][1]), k3 = bfhi(kv[j][1]);
            float s2 = k0 * k0 + k1 * k1 + k2 * k2 + k3 * k3;
#pragma unroll
            for (int m = 32; m >= 1; m >>= 1) { ss += __shfl_xor(ss, m); s2 += __shfl_xor(s2, m); }
            const float rinv = rsqrtf(ss * (1.f / 384.f) + EPS), rinv2 = rsqrtf(s2 * (1.f / 256.f) + EPS);
#pragma unroll
            for (int i = 0; i < 3; ++i) *(unsigned*)(CQN + (size_t)r * 384 + 2 * lane + 128 * i) = pk2(bflo(q[j][i]) * rinv * qg[2 * i], bfhi(q[j][i]) * rinv * qg[2 * i + 1]);
            const f32x4 y = {k0 * rinv2 * g4[0], k1 * rinv2 * g4[1], k2 * rinv2 * g4[2], k3 * rinv2 * g4[3]};
            *(u32x2*)(CKVN + (size_t)r * 256 + 4 * lane) = (u32x2){pk2(y[0], y[1]), pk2(y[2], y[3])};
            if (r < TC) {
                *(f32x4*)(P.out + O_CKV + (size_t)r * 256 + 4 * lane) = y;
                if (lane < 32) P.out[O_KROPE + (size_t)r * 32 + lane] = bf2f(kr[j]);
            } }
    }
    for (int r = T + blockIdx.x * 8 + wave; r < TK; r += gridDim.x * 8) {
        const f32x4 y = *(const f32x4*)(P.in[2] + (size_t)(r - T) * 256 + 4 * lane);
        *(u32x2*)(CKVN + (size_t)r * 256 + 4 * lane) = (u32x2){pk2(y[0], y[1]), pk2(y[2], y[3])};
    }
}

__device__ __forceinline__ void rope32(float (&x)[32], const float2* rp) {
#pragma unroll
    for (int a = 0; a < 2; ++a)
#pragma unroll
        for (int i = 0; i < 8; ++i) { const float2 cs = rp[a * 8 + i]; const float x1 = x[16 * a + i], x2 = x[16 * a + 8 + i];
            x[16 * a + i] = x1 * cs.x - x2 * cs.y; x[16 * a + 8 + i] = x2 * cs.x + x1 * cs.y; }
}
__device__ __forceinline__ void p5_qknorm(const Params& P, unsigned char* smraw) {
    unsigned char* ws = P.ws;
    bf16_t* QR = (bf16_t*)(ws + W_QRAW); bf16_t* KV = (bf16_t*)(ws + W_KVRAW);
    const bf16_t* PB = (const bf16_t*)((unsigned char*)P.out + OS_PB);
    bf16_t* VTC = (bf16_t*)(ws + W_VTC); bf16_t* VTS = (bf16_t*)(ws + W_VTS);
    const float2* ROPE = (const float2*)(ws + W_ROPE);
    const float* qn = P.in[16]; const float* kn = P.in[17];
    const int t = tid_opaque();
    for (int it = blockIdx.x; it < TK / 64; it += gridDim.x) {
        const int r = it * 64 + (t >> 3), h = t & 7;
        const bool sample = (r >= TC && r < T);
        const float2* rp = ROPE + (size_t)((r - TC) & 4095) * 16;
        if (r < T) {
            u32x4* qp = (u32x4*)(QR + (size_t)r * 768 + h * 96);
            u32x4 raw[12]; float ss = 0.f;
#pragma unroll
            for (int i = 0; i < 12; ++i) { raw[i] = qp[i];
#pragma unroll
                for (int e = 0; e < 4; ++e) { const float a = bflo(raw[i][e]), b = bfhi(raw[i][e]); ss += a * a + b * b; } }
            const float rinv = rsqrtf(ss * (1.f / 96.f) + EPS), rs = rinv * QSCALE;
#pragma unroll
            for (int i = 0; i < 8; ++i) { u32x4 o;
#pragma unroll
                for (int e = 0; e < 4; ++e) o[e] = pk2(bflo(raw[i][e]) * rs * qn[i * 8 + 2 * e], bfhi(raw[i][e]) * rs * qn[i * 8 + 2 * e + 1]);
                qp[i] = o; }
            float x[32];
#pragma unroll
            for (int i = 0; i < 4; ++i)
#pragma unroll
                for (int e = 0; e < 4; ++e) { x[i * 8 + 2 * e] = bflo(raw[8 + i][e]) * rs * qn[64 + i * 8 + 2 * e]; x[i * 8 + 2 * e + 1] = bfhi(raw[8 + i][e]) * rs * qn[64 + i * 8 + 2 * e + 1]; }
            if (sample) rope32(x, rp);
#pragma unroll
            for (int i = 0; i < 4; ++i) { u32x4 o;
#pragma unroll
                for (int e = 0; e < 4; ++e) o[e] = pk2(x[i * 8 + 2 * e], x[i * 8 + 2 * e + 1]);
                qp[8 + i] = o; }
        }
        if (r < TC) {
            const bf16_t* ck = (const bf16_t*)(ws + W_CKV) + (size_t)r * 256 + h * 32;
            const float rinv = rsqrtf(((const float*)(ws + W_RS))[4 * T + r] * (1.f / 256.f) + EPS);
            float* oc = P.out + O_CKV + (size_t)r * 256 + h * 32;
#pragma unroll
            for (int i = 0; i < 4; ++i) { const u32x4 v = *(const u32x4*)(ck + i * 8); const f32x4 ka = *(const f32x4*)(P.in[14] + h * 32 + i * 8), kb = *(const f32x4*)(P.in[14] + h * 32 + i * 8 + 4);
                *(f32x4*)(oc + i * 8) = (f32x4){bflo(v[0]) * rinv * ka[0], bfhi(v[0]) * rinv * ka[1], bflo(v[1]) * rinv * ka[2], bfhi(v[1]) * rinv * ka[3]};
                *(f32x4*)(oc + i * 8 + 4) = (f32x4){bflo(v[2]) * rinv * kb[0], bfhi(v[2]) * rinv * kb[1], bflo(v[3]) * rinv * kb[2], bfhi(v[3]) * rinv * kb[3]}; }
            const u32x2 kr = *(const u32x2*)(PB + (size_t)r * PB_LD + PB_KROPE + h * 4);
            *(f32x4*)(P.out + O_KROPE + (size_t)r * 32 + h * 4) = (f32x4){bflo(kr[0]), bfhi(kr[0]), bflo(kr[1]), bfhi(kr[1])};
        }
        __builtin_amdgcn_sched_barrier(0);
        u32x4* kp = (u32x4*)(KV + (size_t)r * 1024 + h * 128);
        {
            constexpr int HS = 64 * 72 + 8;
            bf16_t* vs = (bf16_t*)smraw;
            u32x4 vv[8];
#pragma unroll
            for (int i = 0; i < 8; ++i) vv[i] = kp[8 + i];
            bf16_t* vw = vs + h * HS + (t >> 3);
#pragma unroll
            for (int i = 0; i < 8; ++i)
#pragma unroll
                for (int e = 0; e < 4; ++e) { vw[(i * 8 + 2 * e) * 72] = (bf16_t)(vv[i][e] & 0xffffu); vw[(i * 8 + 2 * e + 1) * 72] = (bf16_t)(vv[i][e] >> 16); }
            __syncthreads();
            const int rb = it * 64;
            bf16_t* vt; int lk;
            if (rb < TC) { vt = VTC + (size_t)((rb >> 8) * 8) * 64 * 256 + (rb & 255); lk = 256; }
            else if (rb < T) { const int rr = rb - TC; vt = VTS + (size_t)((rr >> 12) * 8) * 64 * LKS + 256 + (rr & 4095); lk = LKS; }
            else { const int rr = rb - T; vt = VTS + (size_t)((rr >> 8) * 8) * 64 * LKS + (rr & 255); lk = LKS; }
#pragma unroll
            for (int n = 0; n < 8; ++n) { const int vec = t + 512 * n, hd = vec >> 3, sg = vec & 7;
                const u32x4 x = *(const u32x4*)(vs + (hd >> 6) * HS + (hd & 63) * 72 + sg * 8);
                *(u32x4*)(vt + (size_t)hd * lk + sg * 8) = x; }
            __syncthreads();
        }
        __builtin_amdgcn_sched_barrier(0);
        {
            u32x4 raw[8]; float x[32]; float ss = 0.f;
#pragma unroll
            for (int i = 0; i < 8; ++i) { raw[i] = kp[i];
#pragma unroll
                for (int e = 0; e < 4; ++e) { const float a = bflo(raw[i][e]), b = bfhi(raw[i][e]); ss += a * a + b * b; } }
            if (r < T) {
                const u32x4* pp = (const u32x4*)(PB + (size_t)r * PB_LD + PB_KROPE);
#pragma unroll
                for (int i = 0; i < 4; ++i) { const u32x4 v = pp[i];
#pragma unroll
                    for (int e = 0; e < 4; ++e) { x[i * 8 + 2 * e] = bflo(v[e]); x[i * 8 + 2 * e + 1] = bfhi(v[e]); } }
            } else {
                const f32x4* pp = (const f32x4*)(P.in[3] + (size_t)(r - T) * 32);
#pragma unroll
                for (int i = 0; i < 8; ++i) { const f32x4 v = pp[i];
#pragma unroll
                    for (int e = 0; e < 4; ++e) x[i * 4 + e] = v[e]; }
            }
#pragma unroll
            for (int d = 0; d < 32; ++d) ss += x[d] * x[d];
            const float rinv = rsqrtf(ss * (1.f / 96.f) + EPS);
#pragma unroll
            for (int i = 0; i < 8; ++i) { u32x4 o;
#pragma unroll
                for (int e = 0; e < 4; ++e) o[e] = pk2(bflo(raw[i][e]) * rinv * kn[i * 8 + 2 * e], bfhi(raw[i][e]) * rinv * kn[i * 8 + 2 * e + 1]);
                kp[i] = o; }
#pragma unroll
            for (int d = 0; d < 32; ++d) x[d] = x[d] * rinv * kn[64 + d];
            if (sample) rope32(x, rp);
#pragma unroll
            for (int i = 0; i < 4; ++i) { u32x4 o;
#pragma unroll
                for (int e = 0; e < 4; ++e) o[e] = pk2(x[i * 8 + 2 * e], x[i * 8 + 2 * e + 1]);
                kp[8 + i] = o; }
        }
    }
}

constexpr int GL_GA = 0;
constexpr int GL_SEG = GL_GA + 64 * 32 * 4;
constexpr int GL_QR = GL_SEG + 8 * 64 * 4;
constexpr int GL_KR = GL_QR + 64 * 72 * 2;
constexpr int GL_QS = GL_KR + 64 * 72 * 2;
constexpr int GL_KS = GL_QS + 64 * 72 * 2;
constexpr int GL_SC = GL_KS + 64 * 72 * 2;
constexpr int GL_VT = GL_SC + 64 * 72 * 2;
constexpr int GL_ST = GL_VT + 128 * 72 * 2;
constexpr int GL_END = GL_ST + 2 * 128 * 72 * 2;
static_assert(GL_END <= 128 * 1024 && 64 * 132 * 4 <= 2 * 128 * 72 * 2, "GLA LDS");

__device__ __forceinline__ void gla_load_w(const Params& P, int h, int d, float (&w)[2][16], float (&bb)[2]) {
#pragma unroll
    for (int dir = 0; dir < 2; ++dir) {
#pragma unroll
        for (int r = 0; r < 16; ++r) w[dir][r] = P.in[18][(size_t)dir * 4096 + r * 256 + h * 64 + d];
        bb[dir] = P.in[19][dir * 256 + h * 64 + d]; }
}
__device__ __forceinline__ void gla_cum(const float (&w)[16], float b, int dir, unsigned char* sm, int d, int seg, float (&cum)[8], float& last) {
    const float* gaL = (const float*)(sm + GL_GA); float* segL = (float*)(sm + GL_SEG);
    float la[8];
#pragma unroll
    for (int ii = 0; ii < 8; ++ii) { float z = b; const float* g = gaL + (seg * 8 + ii) * 32 + dir * 16;
#pragma unroll
        for (int r = 0; r < 16; ++r) z += g[r] * w[r];
        la[ii] = (fminf(z, 0.f) - __logf(1.f + __expf(-fabsf(z)))) * (1.f / 16.f); }
    if (dir == 0) { cum[0] = la[0];
#pragma unroll
        for (int ii = 1; ii < 8; ++ii) cum[ii] = cum[ii - 1] + la[ii];
        segL[seg * 64 + d] = cum[7]; }
    else { cum[7] = la[7];
#pragma unroll
        for (int ii = 6; ii >= 0; --ii) cum[ii] = cum[ii + 1] + la[ii];
        segL[seg * 64 + d] = cum[0]; }
    __syncthreads();
    float off = 0.f, tot = 0.f;
#pragma unroll
    for (int s = 0; s < 8; ++s) { const float v = segL[s * 64 + d]; tot += v; if (dir == 0 ? (s < seg) : (s > seg)) off += v; }
#pragma unroll
    for (int ii = 0; ii < 8; ++ii) cum[ii] += off;
    last = tot;
}
__device__ __forceinline__ f32x16 mfma32(bf16x8 a, bf16x8 b, f32x16 c) { return __builtin_amdgcn_mfma_f32_32x32x16_bf16(a, b, c, 0, 0, 0); }
__device__ __forceinline__ f32x16 tile_mm64(const bf16_t* A, int m0, const bf16_t* Bt, int n0, f32x16 acc, int lane) {
    const int rr = lane & 31, hh = lane >> 5;
#pragma unroll
    for (int ks = 0; ks < 4; ++ks) { const bf16x8 a = *(const bf16x8*)(A + (m0 + rr) * 72 + ks * 16 + 8 * hh), b = *(const bf16x8*)(Bt + (n0 + rr) * 72 + ks * 16 + 8 * hh); acc = mfma32(a, b, acc); }
    return acc;
}
#define GLA_LD_GA(row0) (*(const u32x4*)(PB + (size_t)((row0) + (t >> 2)) * PB_LD + PB_GA + (t & 3) * 8))
#define GLA_LD_V(row0, n) (*(const u32x4*)(PB + (size_t)((row0) + ((t + 512 * (n)) >> 4)) * PB_LD + PB_GV + h * 128 + ((t + 512 * (n)) & 15) * 8))
#define GLA_LD_QK(row0, off) (*(const u32x4*)(PB + (size_t)((row0) + (t >> 3)) * PB_LD + (off) + h * 64 + (t & 7) * 8))
__device__ __forceinline__ void gla_stage_ga(unsigned char* sm, u32x4 r, int t) {
    if (t < 256) { float* g = (float*)(sm + GL_GA) + (t >> 2) * 32 + (t & 3) * 8;
        *(f32x4*)g = (f32x4){bflo(r[0]), bfhi(r[0]), bflo(r[1]), bfhi(r[1])}; *(f32x4*)(g + 4) = (f32x4){bflo(r[2]), bfhi(r[2]), bflo(r[3]), bfhi(r[3])}; }
}
#define GLA_LD_V16(row0, arr) do { const bf16_t* vp_ = PB + (size_t)((row0) + (t >> 7) * 16) * PB_LD + PB_GV + h * 128 + (t & 127); \
        _Pragma("unroll") for (int jj_ = 0; jj_ < 16; ++jj_) arr[jj_] = vp_[(size_t)jj_ * PB_LD]; } while (0)
__device__ __forceinline__ void gla_stage_v16(unsigned char* sm, const bf16_t (&a)[16], int t) {
    bf16_t* vT = (bf16_t*)(sm + GL_VT) + (t & 127) * 72 + (t >> 7) * 16;
    *(u32x4*)vT = (u32x4){(unsigned)a[0] | ((unsigned)a[1] << 16), (unsigned)a[2] | ((unsigned)a[3] << 16), (unsigned)a[4] | ((unsigned)a[5] << 16), (unsigned)a[6] | ((unsigned)a[7] << 16)};
    *(u32x4*)(vT + 8) = (u32x4){(unsigned)a[8] | ((unsigned)a[9] << 16), (unsigned)a[10] | ((unsigned)a[11] << 16), (unsigned)a[12] | ((unsigned)a[13] << 16), (unsigned)a[14] | ((unsigned)a[15] << 16)};
}
__device__ __forceinline__ void gla_stage_vT(unsigned char* sm, u32x4 r, int p) {
    bf16_t* vT = (bf16_t*)(sm + GL_VT) + (p & 15) * 8 * 72 + (p >> 4);
#pragma unroll
    for (int e = 0; e < 4; ++e) { vT[(2 * e) * 72] = (bf16_t)(r[e] & 0xffffu); vT[(2 * e + 1) * 72] = (bf16_t)(r[e] >> 16); }
}

__device__ __forceinline__ void gla_pass1(const Params& P, unsigned char* sm) {
    const bf16_t* PB = (const bf16_t*)((unsigned char*)P.out + OS_PB);
    bf16_t* DS = (bf16_t*)(P.ws + W_DS); float* E = (float*)((unsigned char*)P.out + OS_E);
    const int t = tid_opaque(), lane = t & 63, wv = t >> 6, d = t & 63, seg = t >> 6;
    bf16_t* kT = (bf16_t*)(sm + GL_KS); const bf16_t* vT = (const bf16_t*)(sm + GL_VT); const bf16_t* kr = (const bf16_t*)(sm + GL_KR);
    int hw = -1; float w[2][16], bb[2];
    for (int item = blockIdx.x; item < 1536; item += gridDim.x) {
        const int cgk = item >> 2, h = item & 3, row0 = cgk * 64;
        if (h != hw) { gla_load_w(P, h, d, w, bb); hw = h; }
        { u32x4 rga = {0u, 0u, 0u, 0u}; if (t < 256) rga = GLA_LD_GA(row0); const u32x4 rk = GLA_LD_QK(row0, PB_GK); bf16_t rv[16]; GLA_LD_V16(row0, rv);
          gla_stage_ga(sm, rga, t); gla_stage_v16(sm, rv, t);
          *(u32x4*)(sm + GL_KR + ((t >> 3) * 72 + (t & 7) * 8) * 2) = rk; }
        __syncthreads();
        for (int dir = 0; dir < 2; ++dir) {
            float cum[8], last;
            gla_cum(w[dir], bb[dir], dir, sm, d, seg, cum, last);
            unsigned pk[4];
#pragma unroll
            for (int jj = 0; jj < 4; ++jj) {
                const float k0 = bf2f(kr[(seg * 8 + 2 * jj) * 72 + d]) * __expf(last - cum[2 * jj]);
                const float k1 = bf2f(kr[(seg * 8 + 2 * jj + 1) * 72 + d]) * __expf(last - cum[2 * jj + 1]);
                pk[jj] = pk2(k0, k1); }
            *(u32x4*)(kT + d * 72 + seg * 8) = (u32x4){pk[0], pk[1], pk[2], pk[3]};
            if (seg == 0) E[(size_t)(item * 2 + dir) * 64 + d] = __expf(last);
            __syncthreads();
            const int mt = wv >> 1, nt = wv & 1;
            f32x16 acc;
#pragma unroll
            for (int i = 0; i < 16; ++i) acc[i] = 0.f;
            acc = tile_mm64(vT, mt * 32, kT, nt * 32, acc, lane);
            bf16_t* o = DS + (size_t)(item * 2 + dir) * 8192 + nt * 32 + (lane & 31);
#pragma unroll
            for (int i = 0; i < 16; ++i) o[(size_t)(mt * 32 + (i & 3) + 8 * (i >> 2) + 4 * (lane >> 5)) * 64] = f2bf(acc[i]);
            __syncthreads();
        }
    }
}

template <int NC, int BATCH>
__device__ __forceinline__ void gla_scan_chain(bf16_t* DS, const float* E, int cg0, int h, int dir, int e, float s0, float s1, float* fin) {
    const int dk = e & 63, dv = e >> 6;
    for (int st0 = 0; st0 < NC; st0 += BATCH) {
        unsigned ds[BATCH]; float2 ee[BATCH];
#pragma unroll
        for (int i = 0; i < BATCH; ++i) { const int st = st0 + i, c = dir == 0 ? st : NC - 1 - st; const size_t idx = (size_t)((cg0 + c) * 4 + h) * 2 + dir;
            ds[i] = *(const unsigned*)(DS + idx * 8192 + e); ee[i] = *(const float2*)(E + idx * 64 + dk); }
#pragma unroll
        for (int i = 0; i < BATCH; ++i) { const int st = st0 + i, c = dir == 0 ? st : NC - 1 - st; const size_t idx = (size_t)((cg0 + c) * 4 + h) * 2 + dir;
            *(unsigned*)(DS + idx * 8192 + e) = pk2(s0, s1);
            s0 = ee[i].x * s0 + bflo(ds[i]); s1 = ee[i].y * s1 + bfhi(ds[i]); }
    }
    if (fin) { fin[dk * 128 + dv] = s0; fin[(dk + 1) * 128 + dv] = s1; }
}
__device__ __forceinline__ void gla_pass2(const Params& P) {
    bf16_t* DS = (bf16_t*)(P.ws + W_DS); const float* E = (const float*)((unsigned char*)P.out + OS_E);
    const int t = tid_opaque();
    for (int it = blockIdx.x; it < 256; it += gridDim.x) {
        if (it < 256) { const int part = it & 7, dir = (it >> 3) & 1, h = (it >> 4) & 3, b = it >> 6, e = (part * 512 + t) * 2;
            const float* s0p = P.in[4] + (size_t)((b * 2 + dir) * 4 + h) * 8192 + (e & 63) * 128 + (e >> 6);
            gla_scan_chain<64, 16>(DS, E, 128 + b * 64, h, dir, e, s0p[0], s0p[128], nullptr);
        } else { const int i2 = it - 256, part = i2 & 7, dir = (i2 >> 3) & 1, h = (i2 >> 4) & 3, b = i2 >> 6, e = (part * 512 + t) * 2;
            gla_scan_chain<4, 4>(DS, E, b * 4, h, dir, e, 0.f, 0.f, P.out + O_STATE + (size_t)((b * 2 + dir) * 4 + h) * 8192);
        }
    }
    for (int it0 = blockIdx.x * 4; it0 < 2048; it0 += gridDim.x * 4) {
        unsigned ds[4][4]; float2 ee[4][4];
#pragma unroll
        for (int q = 0; q < 4; ++q) { const int i2 = it0 + q, part = i2 & 7, dir = (i2 >> 3) & 1, h = (i2 >> 4) & 3, b = i2 >> 6, e = (part * 512 + t) * 2;
#pragma unroll
            for (int st = 0; st < 4; ++st) { const int c = dir == 0 ? st : 3 - st; const size_t idx = (size_t)((b * 4 + c) * 4 + h) * 2 + dir;
                ds[q][st] = *(const unsigned*)(DS + idx * 8192 + e); ee[q][st] = *(const float2*)(E + idx * 64 + (e & 63)); } }
#pragma unroll
        for (int q = 0; q < 4; ++q) { const int i2 = it0 + q, part = i2 & 7, dir = (i2 >> 3) & 1, h = (i2 >> 4) & 3, b = i2 >> 6, e = (part * 512 + t) * 2;
            float s0 = 0.f, s1 = 0.f;
#pragma unroll
            for (int st = 0; st < 4; ++st) { const int c = dir == 0 ? st : 3 - st; const size_t idx = (size_t)((b * 4 + c) * 4 + h) * 2 + dir;
                *(unsigned*)(DS + idx * 8192 + e) = pk2(s0, s1);
                s0 = ee[q][st].x * s0 + bflo(ds[q][st]); s1 = ee[q][st].y * s1 + bfhi(ds[q][st]); }
            float* fin = P.out + O_STATE + (size_t)((b * 2 + dir) * 4 + h) * 8192;
            fin[(e & 63) * 128 + (e >> 6)] = s0; fin[((e & 63) + 1) * 128 + (e >> 6)] = s1; }
    }
}

__device__ __forceinline__ void gla_pass3(const Params& P, unsigned char* sm) {
    const bf16_t* PB = (const bf16_t*)((unsigned char*)P.out + OS_PB);
    const bf16_t* SP = (const bf16_t*)(P.ws + W_DS);
    bf16_t* ATT = (bf16_t*)(P.ws + W_R1);
    const float* gn = P.in[20];
    const int t = tid_opaque(), lane = t & 63, wv = t >> 6, d = t & 63, seg = t >> 6;
    const bf16_t* qr = (const bf16_t*)(sm + GL_QR); const bf16_t* kr = (const bf16_t*)(sm + GL_KR);
    bf16_t* qs = (bf16_t*)(sm + GL_QS); bf16_t* ks = (bf16_t*)(sm + GL_KS); bf16_t* sc = (bf16_t*)(sm + GL_SC);
    const bf16_t* vT = (const bf16_t*)(sm + GL_VT); bf16_t* ST = (bf16_t*)(sm + GL_ST); float* ob = (float*)(sm + GL_ST);
    int hw = -1; float w[2][16], bb[2];
    u32x4 rga = {0u, 0u, 0u, 0u}, rq, rk, rs00, rs01, rs10, rs11, rg0, rg1; bf16_t rv[16];
#define G3_LOAD(it_) do { const int h = (it_) & 3, row0_ = ((it_) >> 2) * 64; \
        if (t < 256) rga = GLA_LD_GA(row0_); GLA_LD_V16(row0_, rv); rq = GLA_LD_QK(row0_, PB_GQ); rk = GLA_LD_QK(row0_, PB_GK); \
        const bf16_t* sp_ = SP + (size_t)((it_) * 2) * 8192 + (size_t)t * 8; rs00 = *(const u32x4*)sp_; rs01 = *(const u32x4*)(sp_ + 4096); rs10 = *(const u32x4*)(sp_ + 8192); rs11 = *(const u32x4*)(sp_ + 8192 + 4096); \
        const bf16_t* gp_ = PB + (size_t)(row0_ + (t >> 3)) * PB_LD + PB_GG + h * 128 + (t & 7) * 16; rg0 = *(const u32x4*)gp_; rg1 = *(const u32x4*)(gp_ + 8); } while (0)
    int item = blockIdx.x;
    if (item < 1536) G3_LOAD(item);
    for (; item < 1536; item += gridDim.x) {
        const int cgk = item >> 2, h = item & 3, row0 = cgk * 64;
        if (h != hw) { gla_load_w(P, h, d, w, bb); hw = h; }
        gla_stage_ga(sm, rga, t); gla_stage_v16(sm, rv, t);
        *(u32x4*)(sm + GL_QR + ((t >> 3) * 72 + (t & 7) * 8) * 2) = rq;
        *(u32x4*)(sm + GL_KR + ((t >> 3) * 72 + (t & 7) * 8) * 2) = rk;
        *(u32x4*)(ST + (t >> 3) * 72 + (t & 7) * 8) = rs00; *(u32x4*)(ST + (64 + (t >> 3)) * 72 + (t & 7) * 8) = rs01;
        *(u32x4*)(ST + 128 * 72 + (t >> 3) * 72 + (t & 7) * 8) = rs10; *(u32x4*)(ST + 128 * 72 + (64 + (t >> 3)) * 72 + (t & 7) * 8) = rs11;
        const u32x4 g0 = rg0, g1 = rg1;
        __syncthreads();
        if (item + (int)gridDim.x < 1536) G3_LOAD(item + (int)gridDim.x);
        f32x16 oacc;
#pragma unroll
        for (int i = 0; i < 16; ++i) oacc[i] = 0.f;
        for (int dir = 0; dir < 2; ++dir) {
            float cum[8], last;
            gla_cum(w[dir], bb[dir], dir, sm, d, seg, cum, last);
#pragma unroll
            for (int ii = 0; ii < 8; ++ii) { const int o_ = (seg * 8 + ii) * 72 + d;
                qs[o_] = f2bf(bf2f(qr[o_]) * 0.125f * __expf(cum[ii]));
                ks[o_] = f2bf(bf2f(kr[o_]) * __expf(-cum[ii])); }
            __syncthreads();
            if (wv < 4) { const int mt = wv >> 1, nt = wv & 1;
                f32x16 s_;
#pragma unroll
                for (int i = 0; i < 16; ++i) s_[i] = 0.f;
                s_ = tile_mm64(qs, mt * 32, ks, nt * 32, s_, lane);
                const int j = nt * 32 + (lane & 31);
#pragma unroll
                for (int i = 0; i < 16; ++i) { const int ir = mt * 32 + (i & 3) + 8 * (i >> 2) + 4 * (lane >> 5);
                    const bool keep = dir == 0 ? (j <= ir) : (j >= ir);
                    sc[ir * 72 + j] = f2bf(keep ? s_[i] : 0.f); } }
            __syncthreads();
            { const int mt = wv >> 2, nt = wv & 3;
              oacc = tile_mm64(sc, mt * 32, vT, nt * 32, oacc, lane);
              oacc = tile_mm64(qs, mt * 32, ST + dir * 128 * 72, nt * 32, oacc, lane); }
            __syncthreads();
        }
        { const int mt = wv >> 2, nt = wv & 3;
#pragma unroll
          for (int i = 0; i < 16; ++i) ob[(mt * 32 + (i & 3) + 8 * (i >> 2) + 4 * (lane >> 5)) * 132 + nt * 32 + (lane & 31)] = oacc[i]; }
        __syncthreads();
        { const int i = t >> 3, sub = t & 7; float v[16]; float ss = 0.f;
#pragma unroll
          for (int c = 0; c < 16; ++c) { v[c] = ob[i * 132 + sub * 16 + c]; ss += v[c] * v[c]; }
          ss += __shfl_xor(ss, 1); ss += __shfl_xor(ss, 2); ss += __shfl_xor(ss, 4);
          const float rinv = rsqrtf(ss * (1.f / 128.f) + EPS);
          unsigned o[8];
#pragma unroll
          for (int c = 0; c < 8; ++c) { const unsigned gw = c < 4 ? g0[c & 3] : g1[c & 3]; const float ga = bflo(gw), gb = bfhi(gw);
              const float y0 = v[2 * c] * rinv * gn[sub * 16 + 2 * c] * ga * sigmoidf_(ga), y1 = v[2 * c + 1] * rinv * gn[sub * 16 + 2 * c + 1] * gb * sigmoidf_(gb);
              o[c] = pk2(y0, y1); }
          u32x4* op = (u32x4*)(ATT + (size_t)(row0 + i) * 1024 + 512 + h * 128 + sub * 16);
          op[0] = (u32x4){o[0], o[1], o[2], o[3]}; op[1] = (u32x4){o[4], o[5], o[6], o[7]}; }
        __syncthreads();
    }
#undef G3_LOAD
}

constexpr int AT_KS = 0;
constexpr int AT_VS = AT_KS + 2 * 64 * 104 * 2;
template <int QT>
__device__ __forceinline__ void attn_item(const bf16_t* Q, const bf16_t* KV, const bf16_t* vt, bf16_t* ATT, bf16_t* Ks, bf16_t* Vs,
                                          int h, int q0, int nkt, int lk, int krow_a, int krow_b, float negCB, int t) {
    const int lane = t & 63, wv = t >> 6, rr = lane & 31, hh = lane >> 5;
    const int kkey0 = t / 12, kseg0 = t % 12, kkey1 = (512 + t) / 12, kseg1 = (512 + t) % 12, vdv = t >> 3, vseg = t & 7;
    u32x4 kr0, kr1 = {0u, 0u, 0u, 0u}, vr;
#define AT_LOAD(kt) do { const int kb = ((kt) < 4 ? krow_a + (kt) * 64 : krow_b + ((kt) - 4) * 64); \
        kr0 = *(const u32x4*)(KV + (size_t)(kb + kkey0) * 1024 + h * 128 + kseg0 * 8); \
        if (t < 256) kr1 = *(const u32x4*)(KV + (size_t)(kb + kkey1) * 1024 + h * 128 + kseg1 * 8); \
        vr = *(const u32x4*)(vt + (size_t)vdv * lk + (kt) * 64 + vseg * 8); } while (0)
    AT_LOAD(0);
    bf16x8 qf[QT][6];
#pragma unroll
    for (int qt = 0; qt < QT; ++qt) { const bf16_t* qp = Q + (size_t)(q0 + (wv * QT + qt) * 32 + rr) * 768 + h * 96 + 8 * hh;
#pragma unroll
        for (int ks = 0; ks < 6; ++ks) qf[qt][ks] = *(const bf16x8*)(qp + ks * 16); }
    f32x16 O[QT][2];
    float lsum[QT];
#pragma unroll
    for (int qt = 0; qt < QT; ++qt) { lsum[qt] = 0.f;
#pragma unroll
        for (int i = 0; i < 16; ++i) { O[qt][0][i] = 0.f; O[qt][1][i] = 0.f; } }
    for (int kt = 0; kt < nkt; ++kt) {
        bf16_t* Kb = Ks + (kt & 1) * 64 * 104; bf16_t* Vb = Vs + (kt & 1) * 64 * 72;
        *(u32x4*)(Kb + kkey0 * 104 + kseg0 * 8) = kr0;
        if (t < 256) *(u32x4*)(Kb + kkey1 * 104 + kseg1 * 8) = kr1;
        *(u32x4*)(Vb + vdv * 72 + vseg * 8) = vr;
        __syncthreads();
        if (kt + 1 < nkt) AT_LOAD(kt + 1);
#pragma unroll 1
        for (int sub = 0; sub < 2; ++sub) {
            f32x16 s[QT];
#pragma unroll
            for (int qt = 0; qt < QT; ++qt)
#pragma unroll
                for (int i = 0; i < 16; ++i) s[qt][i] = negCB;
#pragma unroll
            for (int ks = 0; ks < 6; ++ks) { const bf16x8 a = *(const bf16x8*)(Kb + (sub * 32 + rr) * 104 + ks * 16 + 8 * hh);
#pragma unroll
                for (int qt = 0; qt < QT; ++qt) s[qt] = mfma32(a, qf[qt][ks], s[qt]); }
            bf16x8 pb[QT][2];
#pragma unroll
            for (int qt = 0; qt < QT; ++qt) {
#pragma unroll
                for (int i = 0; i < 16; ++i) { s[qt][i] = __builtin_amdgcn_exp2f(s[qt][i]); lsum[qt] += s[qt][i]; }
                const u32x4 p0 = {pk2(s[qt][0], s[qt][1]), pk2(s[qt][2], s[qt][3]), pk2(s[qt][4], s[qt][5]), pk2(s[qt][6], s[qt][7])};
                const u32x4 p1 = {pk2(s[qt][8], s[qt][9]), pk2(s[qt][10], s[qt][11]), pk2(s[qt][12], s[qt][13]), pk2(s[qt][14], s[qt][15])};
                pb[qt][0] = __builtin_bit_cast(bf16x8, p0); pb[qt][1] = __builtin_bit_cast(bf16x8, p1); }
#pragma unroll
            for (int j = 0; j < 2; ++j)
#pragma unroll
                for (int dvt = 0; dvt < 2; ++dvt) {
                    const u32x2 a0 = *(const u32x2*)(Vb + (dvt * 32 + rr) * 72 + sub * 32 + 16 * j + 4 * hh), a1 = *(const u32x2*)(Vb + (dvt * 32 + rr) * 72 + sub * 32 + 16 * j + 8 + 4 * hh);
                    const u32x4 av = {a0[0], a0[1], a1[0], a1[1]};
                    const bf16x8 a = __builtin_bit_cast(bf16x8, av);
#pragma unroll
                    for (int qt = 0; qt < QT; ++qt) O[qt][dvt] = mfma32(a, pb[qt][j], O[qt][dvt]);
                }
        }
    }
#undef AT_LOAD
#pragma unroll
    for (int qt = 0; qt < QT; ++qt) {
        float l = lsum[qt]; l += __shfl_xor(l, 32);
        const float inv = 1.f / l;
        bf16_t* op = ATT + (size_t)(q0 + (wv * QT + qt) * 32 + rr) * 1024 + h * 64 + 4 * hh;
#pragma unroll
        for (int g = 0; g < 4; ++g) {
            *(u32x2*)(op + 8 * g) = (u32x2){pk2(O[qt][0][4 * g] * inv, O[qt][0][4 * g + 1] * inv), pk2(O[qt][0][4 * g + 2] * inv, O[qt][0][4 * g + 3] * inv)};
            *(u32x2*)(op + 32 + 8 * g) = (u32x2){pk2(O[qt][1][4 * g] * inv, O[qt][1][4 * g + 1] * inv), pk2(O[qt][1][4 * g + 2] * inv, O[qt][1][4 * g + 3] * inv)};
        }
    }
    __syncthreads();
}
__device__ __forceinline__ void attn_phase(const Params& P, unsigned char* sm) {
    unsigned char* ws = P.ws;
    const bf16_t* Q = (const bf16_t*)(ws + W_QRAW); const bf16_t* KV = (const bf16_t*)(ws + W_KVRAW);
    const bf16_t* VTC = (const bf16_t*)(ws + W_VTC); const bf16_t* VTS = (const bf16_t*)(ws + W_VTS);
    bf16_t* ATT = (bf16_t*)(ws + W_R1);
    const int t = tid_opaque();
    bf16_t* Ks = (bf16_t*)(sm + AT_KS); bf16_t* Vs = (bf16_t*)(sm + AT_VS);
    float negCB;
    { float mq = 0.f, mk = 0.f;
      for (int d = 0; d < 96; ++d) { mq = fmaxf(mq, fabsf(P.in[16][d])); mk = fmaxf(mk, fabsf(P.in[17][d])); }
      negCB = -1.02f * 96.f * mq * mk * QSCALE; }
    for (int item0 = blockIdx.x; item0 < 256; item0 += gridDim.x) {
        const int item = (gridDim.x == 256) ? (item0 & 7) * 32 + (item0 >> 3) : item0;
        const int qb = item & 7, h = (item >> 3) & 7, b = item >> 6;
        attn_item<2>(Q, KV, VTS + (size_t)(b * 8 + h) * 64 * LKS, ATT, Ks, Vs, h, TC + b * 4096 + qb * 512, 68, LKS, T + b * 256, TC + b * 4096, negCB, t);
    }
    for (int item = blockIdx.x; item < 256; item += gridDim.x) {
        const int h = item & 7, b = item >> 3;
        attn_item<1>(Q, KV, VTC + (size_t)(b * 8 + h) * 64 * 256, ATT, Ks, Vs, h, b * 256, 4, 256, b * 256, 0, negCB, t);
    }
}

__device__ __forceinline__ void dwconv_phase(const Params& P, unsigned char* smraw) {
    const bf16_t* U = (const bf16_t*)(P.ws + W_R1); bf16_t* U2 = (bf16_t*)(P.ws + W_R1 + (size_t)T * 1024 * 2);
    float* red = (float*)smraw;
    const int t = tid_opaque(), lane = t & 63, wv = t >> 6, c = 2 * t;
    float* wl = (float*)(smraw + 1024);
    for (int i = t; i < 31 * 1024 / 4; i += 512) ((f32x4*)wl)[i] = ((const f32x4*)P.in[24])[i];
    __syncthreads();
    const float2 bdw = *(const float2*)(P.in[25] + c), lg = *(const float2*)(P.in[26] + c), lb = *(const float2*)(P.in[27] + c);
    const int rows_per = (T / 8 + (int)gridDim.x - 1) / (int)gridDim.x * 8;
    const int R0 = blockIdx.x * rows_per, R1 = (R0 + rows_per < T) ? R0 + rows_per : T;
    unsigned win[38], nxt[8];
#pragma unroll
    for (int k = 0; k < 38; ++k) { const int r = R0 - 15 + k; win[k] = 0u; if (r >= 0 && r < T) win[k] = *(const unsigned*)(U + (size_t)r * 1024 + c); }
    int par = 0;
    for (int r0 = R0; r0 < R1; r0 += 8, par ^= 1) {
        int s0, s1;
        if (r0 < TC) { s0 = r0 & ~255; s1 = s0 + 256; } else { s0 = TC + ((r0 - TC) & ~4095); s1 = s0 + 4096; }
#pragma unroll
        for (int k = 0; k < 8; ++k) { const int r = r0 + 23 + k; nxt[k] = 0u; if (r < T) nxt[k] = *(const unsigned*)(U + (size_t)r * 1024 + c); }
        float a0[8], a1[8];
#pragma unroll
        for (int o = 0; o < 8; ++o) { a0[o] = bdw.x; a1[o] = bdw.y; }
        float x0[38], x1[38];
#pragma unroll
        for (int k = 0; k < 38; ++k) { const int r = r0 - 15 + k; const bool ok = (r >= s0 && r < s1); x0[k] = ok ? bflo(win[k]) : 0.f; x1[k] = ok ? bfhi(win[k]) : 0.f; }
#pragma unroll
        for (int j = 0; j < 31; ++j) { const float2 w = *(const float2*)(wl + j * 1024 + c);
#pragma unroll
            for (int o = 0; o < 8; ++o) { a0[o] += x0[o + j] * w.x; a1[o] += x1[o + j] * w.y; } }
        float* rd = red + par * 128;
#pragma unroll
        for (int o = 0; o < 8; ++o) { const float s1_ = wave_sum(a0[o] + a1[o]), s2_ = wave_sum(a0[o] * a0[o] + a1[o] * a1[o]);
            if (lane == 0) { rd[wv * 16 + o] = s1_; rd[wv * 16 + 8 + o] = s2_; } }
        __syncthreads();
#pragma unroll
        for (int o = 0; o < 8; ++o) { float m = 0.f, v = 0.f;
#pragma unroll
            for (int w = 0; w < 8; ++w) { m += rd[w * 16 + o]; v += rd[w * 16 + 8 + o]; }
            m *= (1.f / 1024.f); v = v * (1.f / 1024.f) - m * m;
            const float rinv = rsqrtf(fmaxf(v, 0.f) + EPS);
            const float y0 = (a0[o] - m) * rinv * lg.x + lb.x, y1 = (a1[o] - m) * rinv * lg.y + lb.y;
            *(unsigned*)(U2 + (size_t)(r0 + o) * 1024 + c) = pk2(y0 * sigmoidf_(y0), y1 * sigmoidf_(y1)); }
#pragma unroll
        for (int k = 0; k < 30; ++k) win[k] = win[k + 8];
#pragma unroll
        for (int k = 0; k < 8; ++k) win[30 + k] = nxt[k];
    }
    __syncthreads();
}

#define XB_TMO      128
#define XB_XCNT(j)  (256  + 64 * (j))
#define XB_XSUB(j)  (1280 + 64 * (j))
#define XB_XGEN(j)  (2304 + 64 * (j))
#define XB_TOP      3328
#define XB_TOPGEN   3392
#define XCD_BAR_WORDS 3456
static_assert(XCD_BAR_WORDS * 4 <= 16384, "barrier words");
#define XB_SPIN_CAP (1u << 18)

__device__ __forceinline__ unsigned xb_ld(unsigned* p)              { return __hip_atomic_load(p, __ATOMIC_RELAXED, __HIP_MEMORY_SCOPE_AGENT); }
__device__ __forceinline__ unsigned xb_add(unsigned* p, unsigned v) { return __hip_atomic_fetch_add(p, v, __ATOMIC_RELAXED, __HIP_MEMORY_SCOPE_AGENT); }
__device__ __forceinline__ unsigned xb_xcc_id() { return (unsigned)__builtin_amdgcn_s_getreg((3 << 11) | 20) & 0xFu; }
#define XB_SPIN(cond, bar) do { unsigned _sp = 0; while (cond) { __builtin_amdgcn_s_sleep(1); \
    if ((++_sp & 255u) == 0u) { if (xb_ld(&(bar)[XB_TMO])) break; if (_sp > XB_SPIN_CAP) { atomicAdd(&(bar)[XB_TMO], 1u); break; } } } } while (0)

struct XcdBarrier {
    unsigned* bar; unsigned x;
    volatile LAS unsigned* st;
};

__device__ __forceinline__ XcdBarrier xcd_barrier_post(unsigned* bar, volatile LAS unsigned* st) {
    XcdBarrier b; b.bar = bar; b.x = xb_xcc_id(); b.st = st;
    if (threadIdx.x == 0) (void)xb_add(&bar[XB_XCNT(b.x)], 1u);
    return b;
}
__device__ __forceinline__ void xcd_barrier_complete(unsigned* bar, unsigned x, unsigned& nloc, unsigned& nx) {
    const unsigned G = gridDim.x * gridDim.y * gridDim.z;
    unsigned sum, cnt, mine, sp = 0u;
    for (;;) {
        sum = 0u; cnt = 0u; mine = 0u;
#pragma unroll
        for (unsigned j = 0; j < 16; ++j) { const unsigned c = xb_ld(&bar[XB_XCNT(j)]); sum += c; cnt += (c > 0u) ? 1u : 0u; mine = (j == x) ? c : mine; }
        if (sum == G) break;
        __builtin_amdgcn_s_sleep(1);
        if ((++sp & 255u) == 0u) { if (xb_ld(&bar[XB_TMO])) break; if (sp > XB_SPIN_CAP) { atomicAdd(&bar[XB_TMO], 1u); break; } }
    }
    nloc = mine > 0u ? mine : 1u; nx = cnt > 0u ? cnt : 1u;
}

__device__ __forceinline__ void xcd_barrier(const XcdBarrier& b) {
    asm volatile("s_waitcnt vmcnt(0)" ::: "memory");
    __syncthreads();
    if (threadIdx.x == 0) {
        unsigned* bar = b.bar;
        __builtin_amdgcn_s_waitcnt(0);
        unsigned nloc = b.st[0], nx = b.st[1];
        if (nloc == 0u) { xcd_barrier_complete(bar, b.x, nloc, nx); b.st[0] = nloc; b.st[1] = nx; }
        const unsigned old = xb_add(&bar[XB_XSUB(b.x)], 1u);
        const unsigned gen = old / nloc;
        if (old + 1u == (gen + 1u) * nloc) {
            __builtin_amdgcn_fence(__ATOMIC_RELEASE, "agent");
            asm volatile("s_waitcnt vmcnt(0)" ::: "memory");
            const unsigned og = xb_add(&bar[XB_TOP], 1u);
            const unsigned tg = og / nx;
            if (og + 1u == (tg + 1u) * nx) xb_add(&bar[XB_TOPGEN], 1u);
            else XB_SPIN(xb_ld(&bar[XB_TOPGEN]) == tg, bar);
            __builtin_amdgcn_fence(__ATOMIC_ACQUIRE, "agent");
            xb_add(&bar[XB_XGEN(b.x)], 1u);
            asm volatile("s_waitcnt vmcnt(0)" ::: "memory");
        } else {
            XB_SPIN(xb_ld(&bar[XB_XGEN(b.x)]) == gen, bar);
            __builtin_amdgcn_fence(__ATOMIC_ACQUIRE, "agent");
            asm volatile("s_waitcnt vmcnt(0)" ::: "memory");
        }
    }
    __syncthreads();
}


constexpr int LDS_BYTES = 128 * 1024 + 256;
#ifndef NREP_ATT
#define NREP_ATT 1
#endif
#ifndef NREP_G1
#define NREP_G1 1
#endif
#ifndef NREP_G3
#define NREP_G3 1
#endif


#ifdef PROBE_E
#define PROBE_SYNC grid.sync(); __builtin_amdgcn_fence(__ATOMIC_ACQUIRE, "agent"); asm volatile("s_waitcnt vmcnt(0)" ::: "memory");
#else
#define PROBE_SYNC
#endif
__global__ void __launch_bounds__(512, 2) fwd_megakernel(Params P) {
    extern __shared__ __attribute__((aligned(16))) unsigned char lds[];
    cg::grid_group grid = cg::this_grid();
    unsigned char* ws = P.ws;
    const float* MOD = (const float*)(ws + W_MOD);
    bf16_t* H = (bf16_t*)(ws + W_R1);
    float* Y = P.out;
    const int G = gridDim.x, bx = blockIdx.x;
    pg8::StaticOrder S;
    volatile LAS unsigned* xst = (volatile LAS unsigned*)((LAS unsigned char*)lds + 128 * 1024);
    if (threadIdx.x < 2) xst[threadIdx.x] = 0u;
    __syncthreads();
    XcdBarrier xbar = xcd_barrier_post((unsigned*)(ws + W_BAR), xst);
#define GSYNC() xcd_barrier(xbar)

#ifndef NO_P0
    p0_prologue(P, lds);
#endif
    if (gridDim.x > 65536u) grid.sync();
    GSYNC();
    norm_phase(P.in[0], P.in[1] - (size_t)TC * 1024, P.in[9], MOD, 0, H);
    p1_aux(P);
    GSYNC();

    { pg8::Gemm g{H, (const bf16_t*)(ws + W_WIN), T, 2304, 1024}; S.init(T, 2304, G, bx);
      pg8::EpiProj E{(bf16_t*)(ws + W_CQ), (bf16_t*)(ws + W_CKV), (bf16_t*)((unsigned char*)P.out + OS_PB), PB_LD, (float*)(ws + W_RS) + 3 * T, (float*)(ws + W_RS) + 4 * T};
      pg8::gemm_phase((LAS unsigned char*)lds, g, S, E); }
    GSYNC();
    { pg8::Gemm g{(const bf16_t*)(ws + W_CQ), (const bf16_t*)(ws + W_WUQ), T, 768, 384}; S.init(T, 768, G, bx);
      pg8::EpiBf16Scaled E{(bf16_t*)(ws + W_QRAW), 768, (const float*)(ws + W_RS) + 3 * T, 1.f / 384.f, T};
      pg8::gemm_phase((LAS unsigned char*)lds, g, S, E); }
    { pg8::Gemm g{(const bf16_t*)(ws + W_CKV), (const bf16_t*)(ws + W_WUKV), TK, 1024, 256}; S.init(TK, 1024, G, G - 1 - bx);
      pg8::EpiBf16Scaled E{(bf16_t*)(ws + W_KVRAW), 1024, (const float*)(ws + W_RS) + 4 * T, 1.f / 256.f, T};
      pg8::gemm_phase((LAS unsigned char*)lds, g, S, E); }
    GSYNC();
#ifndef NO_P5
    p5_qknorm(P, lds);
#endif
#ifndef NO_G1
    { int nrep = NREP_G1; asm volatile("" : "+s"(nrep));
#pragma unroll 1
      for (int rep = 0; rep < nrep; ++rep) gla_pass1(P, lds); }
#endif
    GSYNC();
#ifdef STOP5
    return;
#endif
#ifndef NO_G2
    gla_pass2(P);
#endif
    GSYNC();
#ifdef STOP6
    for (size_t i = (size_t)blockIdx.x * 512 + threadIdx.x; i < (size_t)T * 256; i += (size_t)gridDim.x * 512) ((f32x4*)Y)[i] = (f32x4){0.f, 0.f, 0.f, 0.f};
    return;
#endif
#ifndef NO_AT
    { int nrep = NREP_ATT; asm volatile("" : "+s"(nrep));
#pragma unroll 1
      for (int rep = 0; rep < nrep; ++rep) attn_phase(P, lds); }
#endif
#ifndef NO_G3
    { int nrep = NREP_G3; asm volatile("" : "+s"(nrep));
#pragma unroll 1
      for (int rep = 0; rep < nrep; ++rep) gla_pass3(P, lds); }
#endif
    GSYNC();

    bf16_t* XS = (bf16_t*)(ws + W_XS); const float* GMp = (const float*)(ws + W_GM); float* RSp = (float*)(ws + W_RS); const float* NBp = (const float*)(ws + W_NB);
    bf16_t* ACT = (bf16_t*)(ws + W_R1);
    { pg8::Gemm g{(const bf16_t*)(ws + W_R1), (const bf16_t*)(ws + W_WOUT), T, 1024, 1024}; S.init(T, 1024, G, bx);
      pg8::EpiResGate E{Y, P.in[0], P.in[1] - (size_t)TC * 1024, MOD, 0 * 6 + 2, nullptr, XS, GMp, RSp};
      pg8::gemm_phase((LAS unsigned char*)lds, g, S, E); }
    GSYNC();
    { pg8::Gemm g{XS, (const bf16_t*)(ws + W_WGU), T, 5632, 1024}; S.init(T, 5632, G, bx);
      pg8::EpiGated<0> E{ACT, FFN, NBp, RSp};
      pg8::gemm_phase((LAS unsigned char*)lds, g, S, E); }
    GSYNC();
    { pg8::Gemm g{ACT, (const bf16_t*)(ws + W_WDN), T, 1024, FFN}; S.init(T, 1024, G, bx);
      pg8::EpiResGate E{Y, Y, Y, MOD, 0 * 6 + 5, nullptr, XS, GMp + 5120, RSp + T};
      pg8::gemm_phase((LAS unsigned char*)lds, g, S, E); }
    GSYNC();
    { pg8::Gemm g{XS, (const bf16_t*)(ws + W_WPW1), T, 2048, 1024}; S.init(T, 2048, G, bx);
      pg8::EpiGated<1> E{ACT, 1024, NBp + 5632, RSp + T};
      pg8::gemm_phase((LAS unsigned char*)lds, g, S, E); }
    GSYNC();
    dwconv_phase(P, lds);
    GSYNC();
    { pg8::Gemm g{ACT + (size_t)T * 1024, (const bf16_t*)(ws + W_WPW2), T, 1024, 1024}; S.init(T, 1024, G, bx);
      pg8::EpiResGate E{Y, Y, Y, MOD, 6 + 2, P.in[29], XS, GMp + 2 * 5120, RSp + 2 * T};
      pg8::gemm_phase((LAS unsigned char*)lds, g, S, E); }
    GSYNC();
    { pg8::Gemm g{XS, (const bf16_t*)(ws + W_WGU) + (size_t)5632 * 1024, T, 5632, 1024}; S.init(T, 5632, G, bx);
      pg8::EpiGated<0> E{ACT, FFN, NBp + 7680, RSp + 2 * T};
      pg8::gemm_phase((LAS unsigned char*)lds, g, S, E); }
    GSYNC();
    { pg8::Gemm g{ACT, (const bf16_t*)(ws + W_WDN) + (size_t)1024 * FFN, T, 1024, FFN}; S.init(T, 1024, G, bx);
      pg8::EpiResGate E{Y, Y, Y, MOD, 6 + 5, nullptr, nullptr, nullptr, nullptr};
      pg8::gemm_phase((LAS unsigned char*)lds, g, S, E); }
}

extern "C" void kernel_launch(void* const* d_in, const int* in_sizes, int n_in, void* d_out, int out_size, void* d_ws, size_t ws_size, hipStream_t stream) {
    static int grid_blocks = 0;
    if (!grid_blocks) {
        int dev = 0, cus = 0, per_cu = 0;
        hipGetDevice(&dev);
        hipDeviceGetAttribute(&cus, hipDeviceAttributeMultiprocessorCount, dev);
        hipFuncSetAttribute((const void*)fwd_megakernel, hipFuncAttributeMaxDynamicSharedMemorySize, LDS_BYTES);
        hipOccupancyMaxActiveBlocksPerMultiprocessor(&per_cu, (const void*)fwd_megakernel, 512, LDS_BYTES);
        if (per_cu < 1) { fprintf(stderr, "occupancy query: %d blocks per CU\n", per_cu); per_cu = 1; }
        if (per_cu > 1) per_cu = 1;
        grid_blocks = cus * per_cu;
        if (n_in != 33 || ws_size < W_END) fprintf(stderr, "unexpected n_in %d / ws_size %zu\n", n_in, ws_size);
    }
    Params p{};
    for (int i = 0; i < 33; ++i) p.in[i] = (const float*)d_in[i];
    p.out = (float*)d_out; p.ws = (unsigned char*)d_ws;
    (void)hipMemsetAsync((unsigned char*)d_ws + W_BAR, 0, XCD_BAR_WORDS * 4, stream);
    void* args[] = {&p};
    hipError_t e = hipLaunchCooperativeKernel((const void*)fwd_megakernel, dim3(grid_blocks), dim3(512), args, LDS_BYTES, stream);
    if (e != hipSuccess) fprintf(stderr, "cooperative launch failed: %s (grid %d)\n", hipGetErrorString(e), grid_blocks);
}
```

```cpp
#include <hip/hip_runtime.h>
#include <hip/hip_cooperative_groups.h>
#include <cstdio>
#include <cstdint>
namespace cg = cooperative_groups;

#define LAS __attribute__((address_space(3)))
typedef unsigned short bf16_t;
typedef short bf16x8 __attribute__((ext_vector_type(8)));
typedef short bf16x4 __attribute__((ext_vector_type(4)));
typedef float f32x4 __attribute__((ext_vector_type(4)));
typedef float f32x16 __attribute__((ext_vector_type(16)));
typedef unsigned u32x4 __attribute__((ext_vector_type(4)));
typedef unsigned u32x2 __attribute__((ext_vector_type(2)));

constexpr int D = 1024, TC = 8192, TS = 16384, T = TC + TS, TK = T + 1024;
constexpr int FFN = 2816, PA_LD = 640, PB_LD = 1664;
constexpr int PB_KROPE = 0, PB_GQ = 32, PB_GK = 288, PB_GV = 544, PB_GG = 1056, PB_GA = 1568;
constexpr int LKS = 4352;
constexpr float EPS = 1e-6f;
constexpr float QSCALE = 1.4426950408889634f * 0.10206207261596577f;

constexpr size_t W_WIN = 0;
constexpr size_t W_WUQ = W_WIN + (size_t)2304 * 1024 * 2;
constexpr size_t W_WUKV = W_WUQ + (size_t)768 * 384 * 2;
constexpr size_t W_WOUT = W_WUKV + (size_t)1024 * 256 * 2;
constexpr size_t W_WPW1 = W_WOUT + (size_t)1024 * 1024 * 2;
constexpr size_t W_WPW2 = W_WPW1 + (size_t)2048 * 1024 * 2;
constexpr size_t W_WGU = W_WPW2 + (size_t)1024 * 1024 * 2;
constexpr size_t W_WDN = W_WGU + (size_t)2 * 5632 * 1024 * 2;
constexpr size_t W_MOD = W_WDN + (size_t)2 * 1024 * 2816 * 2;
constexpr size_t W_ROPE = W_MOD + (size_t)5 * 2 * 6 * 1024 * 4;
constexpr size_t W_R1 = W_ROPE + (size_t)4096 * 16 * 8;
constexpr size_t W_R3 = W_R1 + (size_t)T * 1024 * 2;
constexpr size_t W_QRAW = W_R3;
constexpr size_t W_KVRAW = W_R3 + (size_t)T * 768 * 2;
constexpr size_t W_VTC = W_KVRAW + (size_t)TK * 1024 * 2;
constexpr size_t W_VTS = W_VTC + (size_t)32 * 8 * 64 * 256 * 2;
constexpr size_t W_DS = W_VTS + (size_t)4 * 8 * 64 * LKS * 2;
constexpr size_t W_END = W_DS + (size_t)1536 * 2 * 8192 * 2;
static_assert(W_END <= (size_t)256 * 1024 * 1024, "workspace");
static_assert(W_R3 + (size_t)T * FFN * 2 <= (size_t)256 * 1024 * 1024, "workspace (ACT)");
constexpr size_t W_CQN = W_R1;
constexpr size_t W_CKVN = W_R1 + (size_t)T * 384 * 2;
constexpr size_t W_BAR = W_END;
constexpr size_t W_RS = W_BAR + 16384;
constexpr size_t W_GM = W_RS + (size_t)5 * T * 4;
constexpr size_t W_NB = W_GM + (size_t)3 * 5 * 1024 * 4;
constexpr size_t W_AUX_END = W_NB + (size_t)5 * 13312 * 4;
static_assert(W_AUX_END <= (size_t)256 * 1024 * 1024, "aux buffers");
constexpr size_t W_CQ = W_DS, W_CKV = W_DS + (size_t)20 * 1024 * 1024;
constexpr size_t W_XS = W_R1 + (size_t)T * FFN * 2;
static_assert(W_XS + (size_t)T * 1024 * 2 <= W_END, "XS");
constexpr size_t O_CKV = (size_t)T * 1024, O_KROPE = O_CKV + (size_t)8192 * 256, O_STATE = O_KROPE + (size_t)8192 * 32;
constexpr size_t OS_PB = 0, OS_E = (size_t)T * PB_LD * 2;
static_assert(OS_E + (size_t)1536 * 2 * 64 * 4 <= (size_t)T * 1024 * 4, "d_out scratch");

struct Params { const float* in[33]; float* out; unsigned char* ws; };

__device__ __forceinline__ float bf2f(bf16_t v) { return __uint_as_float(((unsigned)v) << 16); }
__device__ __forceinline__ float bflo(unsigned u) { return __uint_as_float(u << 16); }
__device__ __forceinline__ float bfhi(unsigned u) { return __uint_as_float(u & 0xffff0000u); }
typedef __bf16 bf16v2_t __attribute__((ext_vector_type(2)));
typedef float f32x2_t __attribute__((ext_vector_type(2)));
__device__ __forceinline__ unsigned pk2(float lo, float hi) { const f32x2_t v = {lo, hi}; const bf16v2_t b = __builtin_convertvector(v, bf16v2_t); return __builtin_bit_cast(unsigned, b); }
__device__ __forceinline__ bf16_t f2bf(float f) { return (bf16_t)(pk2(f, 0.f) & 0xffffu); }
template <int CTRL> __device__ __forceinline__ float dpp_xadd(float v) { return v + __int_as_float(__builtin_amdgcn_update_dpp(0, __float_as_int(v), CTRL, 0xf, 0xf, true)); }
__device__ __forceinline__ float wave_sum(float v) {
    v = dpp_xadd<0xB1>(v);
    v = dpp_xadd<0x4E>(v);
    v = dpp_xadd<0x141>(v);
    v = dpp_xadd<0x140>(v);
    const int iv = __float_as_int(v);
    return __int_as_float(__builtin_amdgcn_readlane(iv, 0)) + __int_as_float(__builtin_amdgcn_readlane(iv, 16)) + __int_as_float(__builtin_amdgcn_readlane(iv, 32)) + __int_as_float(__builtin_amdgcn_readlane(iv, 48));
}
__device__ __forceinline__ float sigmoidf_(float x) { return __builtin_amdgcn_rcpf(1.f + __expf(-x)); }
__device__ __forceinline__ int tid_opaque() { int t = threadIdx.x; asm volatile("" : "+v"(t)); return t; }
__device__ __forceinline__ int row_group(int r) { return r < TC ? 0 : 1 + ((r - TC) >> 12); }

namespace pg8 {
constexpr int BM = 256, BK = 64, HALF = 128, HTB = HALF * BK * 2, STAGE_BYTES = 8 * HTB, NXCD = 8, WGM = 8;
__host__ __device__ __forceinline__ int lds_byte(int r, int c) { const int st = (r >> 4) * 2 + (c >> 5), rr = r & 15, cc = c & 31, ob = rr * 64 + cc * 2; return st * 1024 + (ob ^ (((ob >> 9) & 1) << 5)); }
__host__ __device__ __forceinline__ void stage_rc(int b, int& R, int& C) { const int st = b / 1024, sb = b % 1024, swz = sb ^ (((sb >> 9) & 1) << 5); R = (st >> 1) * 16 + swz / 64; C = (st & 1) * 32 + (swz % 64) / 2; }
__host__ __device__ __forceinline__ int perm32(int rho) { const int n = rho >> 4, i = rho & 15; return 8 * (i >> 2) + 4 * n + (i & 3); }
struct Unit { int pm, pn, half; };
struct Gemm { const bf16_t* A; const bf16_t* Bt; int M, N, K; };
struct StaticOrder {
    int nM, nN, nwg, G, c;
    int nFull;
    __device__ void init(int M, int N, int G_, int c_) { nM = M / BM; nN = N / BM; nwg = nM * nN; G = G_; c = c_; nFull = (nwg / G) * G; if (2 * (nwg - nFull) > G) nFull = nwg; }
    __device__ bool next(int i, Unit& u) const {
        const long L = (long)i * G + c; if (L >= nFull + 2 * (nwg - nFull)) return false;
        int wgid = (int)L; u.half = 0;
        if (wgid >= nFull) { const int hs = wgid - nFull; u.half = 1 + (hs & 1); wgid = nFull + (hs >> 1); } { const int q = nwg / NXCD, r = nwg % NXCD, xcd = wgid % NXCD, off = wgid / NXCD; wgid = (xcd < r ? xcd * (q + 1) : r * (q + 1) + (xcd - r) * q) + off; }
        const int nig = WGM * nN, gid = wgid / nig, fm = gid * WGM, gsz = (nM - fm) < WGM ? (nM - fm) : WGM;
        u.pm = fm + ((wgid % nig) % gsz); u.pn = (wgid % nig) / gsz; return true;
    }
};

template <class Epi>
__device__ __forceinline__ void gemm_phase(LAS unsigned char* lds, const Gemm g, const StaticOrder& S, const Epi& E) {
    const int tid = tid_opaque(), wid = __builtin_amdgcn_readfirstlane(tid >> 6), lane = tid & 63, wr = wid >> 2, wc = wid & 3, fr = lane & 15, fq = lane >> 4;
    const int K = g.K, nt = K / BK;
    unsigned voffA[2], voffB[2];
#pragma unroll
    for (int i = 0; i < 2; ++i) { int R, C; stage_rc(tid * 16 + i * 8192, R, C); const int Rb = Epi::PERM ? ((R & ~31) + perm32(R & 31)) : R;
        voffA[i] = (unsigned)(R * K + C) * 2u; voffB[i] = (unsigned)(Rb * K + C) * 2u; }
    const size_t kstep = (size_t)(BK * 2);
    const size_t hstep = (size_t)HALF * K * 2;
    const size_t tstep = 2 * hstep;
    const unsigned ldsw = (unsigned)wid * 1024u;
    const int aoff = lds_byte(wr * 64 + fr, fq * 8), boff = lds_byte(wc * 32 + fr, fq * 8);
#define PG8_SA(b, h) (((b) * 2 + (h)) * HTB)
#define PG8_SB(b, h) ((4 + (b) * 2 + (h)) * HTB)
#define PG8_STAGE(bufoff, gbase, voff) do { _Pragma("unroll") for (int _i = 0; _i < 2; ++_i) \
        __builtin_amdgcn_global_load_lds((const unsigned*)((const char*)(gbase) + (voff)[_i]), (LAS unsigned*)(lds + (bufoff) + ldsw + _i * 8192), 16, 0, 0); } while (0)
#define PG8_LDA(dst, b, h) do { _Pragma("unroll") for (int m = 0; m < 4; ++m) _Pragma("unroll") for (int k = 0; k < 2; ++k) dst[m][k] = *(const LAS bf16x8*)(lds + PG8_SA(b, h) + aoff + m * 2048 + k * 1024); } while (0)
#define PG8_LDB(dst, b, h) do { _Pragma("unroll") for (int n = 0; n < 2; ++n) _Pragma("unroll") for (int k = 0; k < 2; ++k) dst[n][k] = *(const LAS bf16x8*)(lds + PG8_SB(b, h) + boff + n * 2048 + k * 1024); } while (0)
#define PG8_MMA(ai, bj, At, Bt) do { __builtin_amdgcn_s_setprio(1); _Pragma("unroll") for (int m = 0; m < 4; ++m) _Pragma("unroll") for (int n = 0; n < 2; ++n) _Pragma("unroll") for (int k = 0; k < 2; ++k) \
        acc[ai][bj][m][n] = __builtin_amdgcn_mfma_f32_16x16x32_bf16(Bt[n][k], At[m][k], acc[ai][bj][m][n], 0, 0, 0); __builtin_amdgcn_s_setprio(0); } while (0)
#define PG8_WAIT_V(n) asm volatile("s_waitcnt vmcnt(" #n ")" ::: "memory")
#define PG8_WAIT_L(n) asm volatile("s_waitcnt lgkmcnt(" #n ")" ::: "memory")
#define PG8_BAR __builtin_amdgcn_s_barrier()
#define PG8_SCHED __builtin_amdgcn_sched_barrier(0)
    Unit cur, nxt; int ui = 0;
    if (!S.next(0, cur)) return;
    f32x4 acc[2][2][4][2];
#pragma unroll
    for (int a = 0; a < 2; ++a)
#pragma unroll
        for (int b = 0; b < 2; ++b)
#pragma unroll
            for (int m = 0; m < 4; ++m)
#pragma unroll
                for (int n = 0; n < 2; ++n) acc[a][b][m][n] = (f32x4){0.f, 0.f, 0.f, 0.f};
    bf16x8 At[4][2], B0[2][2], B1[2][2];
    const char* cA = (const char*)g.A + (size_t)cur.pm * tstep + (cur.half == 2 ? hstep : (size_t)0); const char* cB = (const char*)g.Bt + (size_t)cur.pn * tstep;
    PG8_STAGE(PG8_SB(0, 0), cB, voffB); PG8_STAGE(PG8_SA(0, 0), cA, voffA); PG8_STAGE(PG8_SB(0, 1), cB + hstep, voffB); PG8_STAGE(PG8_SA(0, 1), cA + hstep, voffA);
    if (wr == 1) PG8_BAR;
    PG8_WAIT_V(4); PG8_BAR;
    PG8_STAGE(PG8_SB(1, 0), cB + kstep, voffB); PG8_STAGE(PG8_SA(1, 0), cA + kstep, voffA); PG8_STAGE(PG8_SB(1, 1), cB + hstep + kstep, voffB);
    PG8_WAIT_V(6); PG8_BAR;
    for (;;) {
        const bool has_next = S.next(ui + 1, nxt);
        const char* nA = has_next ? (const char*)g.A + (size_t)nxt.pm * tstep + (nxt.half == 2 ? hstep : (size_t)0) : cA; const bool whole = (cur.half == 0); const char* nB = has_next ? (const char*)g.Bt + (size_t)nxt.pn * tstep : cB;
        for (int t = 0; t < nt; t += 2) {
            const bool last = (t == nt - 2);
            const char* a1 = cA + (size_t)(t + 1) * kstep;
            const char* a2 = last ? nA : cA + (size_t)(t + 2) * kstep; const char* b2 = last ? nB : cB + (size_t)(t + 2) * kstep;
            const char* a3 = a2 + kstep; const char* b3 = b2 + kstep;
            PG8_LDB(B0, 0, 0); PG8_SCHED; PG8_LDA(At, 0, 0); PG8_STAGE(PG8_SA(1, 1), a1 + hstep, voffA);
            PG8_WAIT_L(8); PG8_BAR; PG8_WAIT_L(0); PG8_MMA(0, 0, At, B0); PG8_BAR; PG8_SCHED;
            PG8_LDB(B1, 0, 1); PG8_STAGE(PG8_SB(0, 0), b2, voffB);
            PG8_BAR; PG8_WAIT_L(0); PG8_MMA(0, 1, At, B1); PG8_BAR;
            if (whole) PG8_LDA(At, 0, 1); PG8_STAGE(PG8_SA(0, 0), a2, voffA);
            PG8_BAR; PG8_WAIT_L(0); if (whole) PG8_MMA(1, 0, At, B0); PG8_BAR; PG8_SCHED;
            PG8_STAGE(PG8_SB(0, 1), b2 + hstep, voffB);
            PG8_WAIT_V(6); PG8_BAR; if (whole) PG8_MMA(1, 1, At, B1); PG8_BAR;
            PG8_LDB(B0, 1, 0); PG8_SCHED; PG8_LDA(At, 1, 0); PG8_STAGE(PG8_SA(0, 1), a2 + hstep, voffA);
            PG8_WAIT_L(8); PG8_BAR; PG8_WAIT_L(0); PG8_MMA(0, 0, At, B0); PG8_BAR; PG8_SCHED;
            PG8_LDB(B1, 1, 1); PG8_STAGE(PG8_SB(1, 0), b3, voffB);
            PG8_BAR; PG8_WAIT_L(0); PG8_MMA(0, 1, At, B1); PG8_BAR;
            if (whole) PG8_LDA(At, 1, 1); PG8_STAGE(PG8_SA(1, 0), a3, voffA);
            PG8_BAR; PG8_WAIT_L(0); if (whole) PG8_MMA(1, 0, At, B0); PG8_BAR; PG8_SCHED;
            PG8_STAGE(PG8_SB(1, 1), b3 + hstep, voffB);
            PG8_WAIT_V(6); PG8_BAR; if (whole) PG8_MMA(1, 1, At, B1); PG8_BAR;
        }
        E(acc, cur, wr, wc, fr, fq);
        if (!has_next) break;
#pragma unroll
        for (int a = 0; a < 2; ++a)
#pragma unroll
            for (int b = 0; b < 2; ++b)
#pragma unroll
                for (int m = 0; m < 4; ++m)
#pragma unroll
                    for (int n = 0; n < 2; ++n) acc[a][b][m][n] = (f32x4){0.f, 0.f, 0.f, 0.f};
        cur = nxt; cA = nA; cB = nB; ++ui;
    }
    PG8_WAIT_V(0);
    if (wr == 0) PG8_BAR;
    PG8_BAR;
#undef PG8_SA
#undef PG8_SB
#undef PG8_STAGE
#undef PG8_LDA
#undef PG8_LDB
#undef PG8_MMA
#undef PG8_WAIT_V
#undef PG8_WAIT_L
#undef PG8_BAR
#undef PG8_SCHED
}

typedef const f32x4 (&AccRef)[2][2][4][2];

struct EpiBf16Split {
    static constexpr bool PERM = true;
    bf16_t* O0; int ld0; bf16_t* O1; int ld1; int split;
    __device__ __forceinline__ void operator()(AccRef acc, const Unit& u, int wr, int wc, int fr, int fq) const {
        const int row0 = u.pm * BM + wr * 64 + fr + (u.half == 2 ? HALF : 0); const int nai = u.half ? 1 : 2;
#pragma unroll
        for (int bj = 0; bj < 2; ++bj) {
            const int cb = u.pn * BM + bj * HALF; bf16_t* base; int ld, c;
            if (cb < split) { base = O0; ld = ld0; c = cb; } else { base = O1; ld = ld1; c = cb - split; }
            c += wc * 32 + 8 * fq;
#pragma unroll
            for (int ai = 0; ai < 2; ++ai) if (ai < nai)
#pragma unroll
                for (int m = 0; m < 4; ++m) {
                    const f32x4 v0 = acc[ai][bj][m][0], v1 = acc[ai][bj][m][1];
                    u32x4 o = {pk2(v0[0], v0[1]), pk2(v0[2], v0[3]), pk2(v1[0], v1[1]), pk2(v1[2], v1[3])};
                    *(u32x4*)(base + (size_t)(row0 + ai * HALF + m * 16) * ld + c) = o;
                    __builtin_amdgcn_sched_barrier(0);
                }
        }
    }
};
struct EpiProj {
    static constexpr bool PERM = true;
    bf16_t* CQ; bf16_t* CKV; bf16_t* O1; int ld1; float* rsq; float* rskv;
    __device__ __forceinline__ void operator()(AccRef acc, const Unit& u, int wr, int wc, int fr, int fq) const {
        const int row0 = u.pm * BM + wr * 64 + fr + (u.half == 2 ? HALF : 0); const int nai = u.half ? 1 : 2;
#pragma unroll
        for (int bj = 0; bj < 2; ++bj) {
            const int cb = u.pn * BM + bj * HALF; bf16_t* base; int ld, c; float* rs;
            if (cb < 384) { base = CQ; ld = 384; c = cb; rs = rsq; } else if (cb < 640) { base = CKV; ld = 256; c = cb - 384; rs = rskv; } else { base = O1; ld = ld1; c = cb - 640; rs = nullptr; }
            c += wc * 32 + 8 * fq;
#pragma unroll
            for (int ai = 0; ai < 2; ++ai) if (ai < nai)
#pragma unroll
                for (int m = 0; m < 4; ++m) {
                    const f32x4 v0 = acc[ai][bj][m][0], v1 = acc[ai][bj][m][1];
                    u32x4 o = {pk2(v0[0], v0[1]), pk2(v0[2], v0[3]), pk2(v1[0], v1[1]), pk2(v1[2], v1[3])};
                    *(u32x4*)(base + (size_t)(row0 + ai * HALF + m * 16) * ld + c) = o;
                    if (rs) { float q = v0[0] * v0[0] + v0[1] * v0[1] + v0[2] * v0[2] + v0[3] * v0[3] + v1[0] * v1[0] + v1[1] * v1[1] + v1[2] * v1[2] + v1[3] * v1[3];
                        q += __shfl_xor(q, 16); q += __shfl_xor(q, 32);
                        if (fq == 0) (void)__hip_atomic_fetch_add(rs + row0 + ai * HALF + m * 16, q, __ATOMIC_RELAXED, __HIP_MEMORY_SCOPE_AGENT); }
                    __builtin_amdgcn_sched_barrier(0);
                }
        }
    }
};
struct EpiBf16Scaled {
    static constexpr bool PERM = true;
    bf16_t* O; int ld; const float* rowss; float inv_k; int nscaled;
    __device__ __forceinline__ void operator()(AccRef acc, const Unit& u, int wr, int wc, int fr, int fq) const {
        const int row0 = u.pm * BM + wr * 64 + fr + (u.half == 2 ? HALF : 0); const int nai = u.half ? 1 : 2;
        float rs[2][4];
#pragma unroll
        for (int ai = 0; ai < 2; ++ai)
#pragma unroll
            for (int m = 0; m < 4; ++m) { const int r = row0 + (ai < nai ? ai : 0) * HALF + m * 16; rs[ai][m] = (r < nscaled) ? rowss[r] : -1.f; }
#pragma unroll
        for (int ai = 0; ai < 2; ++ai) if (ai < nai)
#pragma unroll
            for (int m = 0; m < 4; ++m) { const float rinv = rs[ai][m] >= 0.f ? rsqrtf(rs[ai][m] * inv_k + EPS) : 1.f;
#pragma unroll
                for (int bj = 0; bj < 2; ++bj) {
                    const f32x4 v0 = acc[ai][bj][m][0] * rinv, v1 = acc[ai][bj][m][1] * rinv;
                    u32x4 o = {pk2(v0[0], v0[1]), pk2(v0[2], v0[3]), pk2(v1[0], v1[1]), pk2(v1[2], v1[3])};
                    *(u32x4*)(O + (size_t)(row0 + ai * HALF + m * 16) * ld + u.pn * BM + bj * HALF + wc * 32 + 8 * fq) = o; }
                __builtin_amdgcn_sched_barrier(0); }
    }
};
struct EpiResGate {
    static constexpr bool PERM = false;
    float* out; const float* resA; const float* resB; const float* mod; int gate_idx; const float* bias;
    bf16_t* xs; const float* gm; float* rowss;
    __device__ __forceinline__ void operator()(AccRef acc, const Unit& u, int wr, int wc, int fr, int fq) const {
        const int row0 = u.pm * BM + wr * 64 + fr + (u.half == 2 ? HALF : 0), col0 = u.pn * BM + wc * 32 + 4 * fq; const int nai = u.half ? 1 : 2;
        const int g = row_group(u.pm * BM);
        const float* res = (u.pm * BM < TC) ? resA : resB;
        const float* gp = mod + (size_t)(g * 12 + gate_idx) * 1024;
        f32x4 gv[2][2], gmv[2][2], bv[2][2];
#pragma unroll
        for (int bj = 0; bj < 2; ++bj)
#pragma unroll
            for (int n = 0; n < 2; ++n) { const int cc = col0 + bj * HALF + n * 16;
                gv[bj][n] = *(const f32x4*)(gp + cc);
                gmv[bj][n] = xs ? *(const f32x4*)(gm + (size_t)g * 1024 + cc) : (f32x4){0.f, 0.f, 0.f, 0.f};
                bv[bj][n] = bias ? *(const f32x4*)(bias + cc) : (f32x4){0.f, 0.f, 0.f, 0.f}; }
        const int nrow = nai * 4;
        f32x4 rcur[2][2], rnxt[2][2];
#pragma unroll
        for (int bj = 0; bj < 2; ++bj)
#pragma unroll
            for (int n = 0; n < 2; ++n) rcur[bj][n] = *(const f32x4*)(res + (size_t)row0 * 1024 + col0 + bj * HALF + n * 16);
#pragma unroll
        for (int it = 0; it < 8; ++it) if (it < nrow) {
            const int ai = it >> 2, m = it & 3;
            const size_t ro = (size_t)(row0 + ai * HALF + m * 16) * 1024 + col0; float ssq = 0.f;
            if (it + 1 < nrow) { const size_t rn = (size_t)(row0 + ((it + 1) >> 2) * HALF + ((it + 1) & 3) * 16) * 1024 + col0;
#pragma unroll
                for (int bj = 0; bj < 2; ++bj)
#pragma unroll
                    for (int n = 0; n < 2; ++n) rnxt[bj][n] = *(const f32x4*)(res + rn + bj * HALF + n * 16); }
#pragma unroll
            for (int bj = 0; bj < 2; ++bj)
#pragma unroll
                for (int n = 0; n < 2; ++n) {
                    const f32x4 o = rcur[bj][n] + gv[bj][n] * (acc[ai][bj][m][n] + bv[bj][n]);
                    *(f32x4*)(out + ro + bj * HALF + n * 16) = o;
                    if (xs) { const f32x4 y = o * gmv[bj][n];
                        *(u32x2*)(xs + ro + bj * HALF + n * 16) = (u32x2){pk2(y[0], y[1]), pk2(y[2], y[3])};
                        ssq += o[0] * o[0] + o[1] * o[1] + o[2] * o[2] + o[3] * o[3]; } }
            if (xs) { ssq += __shfl_xor(ssq, 16); ssq += __shfl_xor(ssq, 32);
                if (fq == 0) (void)__hip_atomic_fetch_add(rowss + row0 + ai * HALF + m * 16, ssq, __ATOMIC_RELAXED, __HIP_MEMORY_SCOPE_AGENT); }
#pragma unroll
            for (int bj = 0; bj < 2; ++bj)
#pragma unroll
                for (int n = 0; n < 2; ++n) rcur[bj][n] = rnxt[bj][n];
            __builtin_amdgcn_sched_barrier(0); }
    }
};
template <int MODE> struct EpiGated {
    static constexpr bool PERM = true;
    bf16_t* O; int ldo; const float* nb; const float* rowss;
    __device__ __forceinline__ void operator()(AccRef acc, const Unit& u, int wr, int wc, int fr, int fq) const {
        const int row0 = u.pm * BM + wr * 64 + fr + (u.half == 2 ? HALF : 0), c = u.pn * HALF + wc * 32 + 8 * fq; const int nai = u.half ? 1 : 2;
        const float* nbp = nb + (size_t)row_group(u.pm * BM) * 13312 + u.pn * 256 + wc * 32 + 8 * fq;
        f32x4 ba[2], bb[2];
#pragma unroll
        for (int n = 0; n < 2; ++n) { ba[n] = *(const f32x4*)(nbp + 4 * n); bb[n] = *(const f32x4*)(nbp + 128 + 4 * n); }
        float rs[2][4];
#pragma unroll
        for (int ai = 0; ai < 2; ++ai)
#pragma unroll
            for (int m = 0; m < 4; ++m) rs[ai][m] = rowss[row0 + (ai < nai ? ai : 0) * HALF + m * 16];
#pragma unroll
        for (int ai = 0; ai < 2; ++ai) if (ai < nai)
#pragma unroll
            for (int m = 0; m < 4; ++m) {
                float r[8];
                const float rinv = rsqrtf(rs[ai][m] * (1.f / 1024.f) + EPS);
                const f32x2_t rinv2 = {rinv, rinv};
#pragma unroll
                for (int n = 0; n < 2; ++n)
#pragma unroll
                    for (int e = 0; e < 4; e += 2) {
                        const f32x2_t a = __builtin_elementwise_fma((f32x2_t){acc[ai][0][m][n][e], acc[ai][0][m][n][e + 1]}, rinv2, (f32x2_t){ba[n][e], ba[n][e + 1]});
                        const f32x2_t b = __builtin_elementwise_fma((f32x2_t){acc[ai][1][m][n][e], acc[ai][1][m][n][e + 1]}, rinv2, (f32x2_t){bb[n][e], bb[n][e + 1]});
                        const f32x2_t z = ((MODE == 0) ? a : b) * (f32x2_t){-1.4426950408889634f, -1.4426950408889634f};
                        const f32x2_t den = (f32x2_t){__builtin_amdgcn_exp2f(z[0]), __builtin_amdgcn_exp2f(z[1])} + (f32x2_t){1.f, 1.f};
                        const f32x2_t sg = {__builtin_amdgcn_rcpf(den[0]), __builtin_amdgcn_rcpf(den[1])};
                        const f32x2_t o2 = (MODE == 0) ? (a * sg) * b : a * sg;
                        r[n * 4 + e] = o2[0]; r[n * 4 + e + 1] = o2[1]; }
                u32x4 o = {pk2(r[0], r[1]), pk2(r[2], r[3]), pk2(r[4], r[5]), pk2(r[6], r[7])};
                *(u32x4*)(O + (size_t)(row0 + ai * HALF + m * 16) * ldo + c) = o;
                if (m & 1) __builtin_amdgcn_sched_barrier(0);
            }
    }
};
}

__device__ __forceinline__ void conv_tile(const float* __restrict__ W, int K, int N, bf16_t* __restrict__ Wt, int kt, int ntile, int map, int half_n, float* sm) {
    const int t = tid_opaque(), k0 = kt * 64, n0 = ntile * 64;
#pragma unroll
    for (int i = 0; i < 8; ++i) { const int idx = i * 512 + t, kk = idx >> 6, nn = idx & 63; sm[kk * 65 + nn] = W[(size_t)(k0 + kk) * N + n0 + nn]; }
    __syncthreads();
    const int nn = t >> 3, ks = (t & 7) * 8;
    float v[8];
#pragma unroll
    for (int j = 0; j < 8; ++j) v[j] = sm[(ks + j) * 65 + nn];
    int n = n0 + nn, dst;
    if (map == 0) dst = n;
    else { int up = 0; if (n >= half_n) { n -= half_n; up = 128; } dst = (n >> 7) * 256 + (n & 127) + up; }
    u32x4 o = {pk2(v[0], v[1]), pk2(v[2], v[3]), pk2(v[4], v[5]), pk2(v[6], v[7])};
    *(u32x4*)(Wt + (size_t)dst * K + k0 + ks) = o;
    __syncthreads();
}

__device__ __forceinline__ void p0_prologue(const Params& P, unsigned char* smraw) {
    float* sm = (float*)smraw;
    unsigned char* ws = P.ws;
    const int t = tid_opaque();
    constexpr int N_ADA = 256, N_ZERO = 1, N_ROPE = 16, N_CONV = 0;
    constexpr int I_ZERO = N_ADA, I_ROPE = I_ZERO + N_ZERO, I_CONV = I_ROPE + N_ROPE, N_ITEMS = I_CONV + N_CONV;
    for (int it = blockIdx.x; it < N_ITEMS; it += gridDim.x) {
        if (it < N_ADA) {
            const int layer = it >> 7, cch = it & 127;
            float* sc = sm;
            float* red = sm + 5 * 1024;
            for (int i = t; i < 5 * 1024; i += 512) { const int g = i >> 10, k = i & 1023; const float c = (g == 0) ? P.in[6][k] : P.in[5][(g - 1) * 1024 + k]; sc[i] = c * sigmoidf_(c); }
            __syncthreads();
            if (t < 384) {
                const int cg4 = t % 12, kg = t / 12;
                const float* w = P.in[7] + (size_t)layer * 1024 * 6144 + (size_t)(kg * 32) * 6144 + cch * 48 + cg4 * 4;
                f32x4 a[5];
#pragma unroll
                for (int g = 0; g < 5; ++g) a[g] = (f32x4){0.f, 0.f, 0.f, 0.f};
#pragma unroll 16
                for (int kk = 0; kk < 32; ++kk) { const f32x4 w4 = *(const f32x4*)(w + (size_t)kk * 6144);
#pragma unroll
                    for (int g = 0; g < 5; ++g) a[g] += w4 * sc[g * 1024 + kg * 32 + kk]; }
#pragma unroll
                for (int g = 0; g < 5; ++g) *(f32x4*)(red + (kg * 5 + g) * 48 + cg4 * 4) = a[g];
            }
            __syncthreads();
            if (t < 240) { const int g = t / 48, c = t % 48; float s_ = 0.f;
#pragma unroll 8
                for (int k2 = 0; k2 < 32; ++k2) s_ += red[(k2 * 5 + g) * 48 + c];
                const int col = cch * 48 + c;
                ((float*)(ws + W_MOD))[(size_t)(g * 2 + layer) * 6144 + col] = s_ + P.in[8][layer * 6144 + col]; }
            __syncthreads();
        } else if (it < I_ROPE) {
            u32x4* z = (u32x4*)(ws + W_WIN + (size_t)2240 * 1024 * 2);
            for (int i = t; i < 64 * 1024 * 2 / 16; i += 512) z[i] = (u32x4){0u, 0u, 0u, 0u};
        } else if (it < I_CONV) {
            const int base = (it - I_ROPE) * 4096;
            float2* rp = (float2*)(ws + W_ROPE);
            for (int i = t; i < 4096; i += 512) { const int e = base + i, l = e >> 4, f = e & 15, ax = f >> 3, fi = f & 7;
                const float pos = (float)(ax == 0 ? (l >> 6) : (l & 63));
                const float invf = powf(10000.f, -(float)(2 * fi) / 16.f);
                float s, c; sincosf(pos * invf, &s, &c); rp[e] = make_float2(c, s); }
        }
    }
    struct Job { const float* W; bf16_t* Wt; const float* ksc; int K, N, map, half, k0, n0; };
#define P0_DECODE(tile_, J) do { int tl = (tile_); (J).map = 0; (J).half = 1 << 30; (J).ksc = nullptr; \
        if (tl < 560) { (J).W = P.in[11]; (J).K = 1024; (J).N = 2240; (J).Wt = (bf16_t*)(ws + W_WIN); } \
        else if ((tl -= 560) < 72) { (J).W = P.in[13]; (J).K = 384; (J).N = 768; (J).Wt = (bf16_t*)(ws + W_WUQ); (J).ksc = P.in[12]; } \
        else if ((tl -= 72) < 64) { (J).W = P.in[15]; (J).K = 256; (J).N = 1024; (J).Wt = (bf16_t*)(ws + W_WUKV); (J).ksc = P.in[14]; } \
        else if ((tl -= 64) < 256) { (J).W = P.in[21]; (J).K = 1024; (J).N = 1024; (J).Wt = (bf16_t*)(ws + W_WOUT); } \
        else if ((tl -= 256) < 512) { (J).W = P.in[22]; (J).K = 1024; (J).N = 2048; (J).Wt = (bf16_t*)(ws + W_WPW1); (J).map = 1; (J).half = 1024; } \
        else if ((tl -= 512) < 256) { (J).W = P.in[28]; (J).K = 1024; (J).N = 1024; (J).Wt = (bf16_t*)(ws + W_WPW2); } \
        else if ((tl -= 256) < 1408) { const int l = tl / 704; tl -= l * 704; (J).W = P.in[30] + (size_t)l * 1024 * FFN; (J).K = 1024; (J).N = FFN; (J).Wt = (bf16_t*)(ws + W_WGU) + (size_t)l * 5632 * 1024; (J).map = 1; } \
        else if ((tl -= 1408) < 1408) { const int l = tl / 704; tl -= l * 704; (J).W = P.in[31] + (size_t)l * 1024 * FFN; (J).K = 1024; (J).N = FFN; (J).Wt = (bf16_t*)(ws + W_WGU) + (size_t)l * 5632 * 1024 + (size_t)128 * 1024; (J).map = 1; } \
        else { tl -= 1408; const int l = tl / 704; tl -= l * 704; (J).W = P.in[32] + (size_t)l * FFN * 1024; (J).K = FFN; (J).N = 1024; (J).Wt = (bf16_t*)(ws + W_WDN) + (size_t)l * 1024 * FFN; } \
        const int nN_ = (J).N / 64; (J).k0 = (tl / nN_) * 64; (J).n0 = (tl % nN_) * 64; } while (0)
#define P0_LOAD(J, v) do { _Pragma("unroll") for (int i_ = 0; i_ < 8; ++i_) { const int idx_ = i_ * 512 + t; v[i_] = (J).W[(size_t)((J).k0 + (idx_ >> 6)) * (J).N + (J).n0 + (idx_ & 63)]; } } while (0)
    {
        Job J, Jn; float v[8];
        int tile = blockIdx.x;
        if (tile < 5944) { P0_DECODE(tile, J); P0_LOAD(J, v); }
        for (; tile < 5944; tile += gridDim.x) {
#pragma unroll
            for (int i = 0; i < 8; ++i) { const int idx = i * 512 + t; sm[(idx >> 6) * 65 + (idx & 63)] = J.ksc ? v[i] * J.ksc[J.k0 + (idx >> 6)] : v[i]; }
            __syncthreads();
            const int nt_ = tile + (int)gridDim.x;
            if (nt_ < 5944) { P0_DECODE(nt_, Jn); P0_LOAD(Jn, v); }
            const int nn = t >> 3, ks = (t & 7) * 8;
            float x[8];
#pragma unroll
            for (int j = 0; j < 8; ++j) x[j] = sm[(ks + j) * 65 + nn];
            int n = J.n0 + nn, dst;
            if (J.map == 0) dst = n;
            else { int up = 0; if (n >= J.half) { n -= J.half; up = 128; } dst = (n >> 7) * 256 + (n & 127) + up; }
            *(u32x4*)(J.Wt + (size_t)dst * J.K + J.k0 + ks) = (u32x4){pk2(x[0], x[1]), pk2(x[2], x[3]), pk2(x[4], x[5]), pk2(x[6], x[7])};
            __syncthreads();
            J = Jn;
        }
    }
#undef P0_DECODE
#undef P0_LOAD
}

__device__ __forceinline__ void norm_phase(const float* xa, const float* xb, const float* gain, const float* mod, int mod_idx, bf16_t* H) {
    const int t_ = tid_opaque(), wave = t_ >> 6, lane = t_ & 63;
    for (int r = blockIdx.x * 8 + wave; r < T; r += gridDim.x * 8) {
        const float* x = (r < TC ? xa : xb) + (size_t)r * 1024;
        const float* sh = mod + (size_t)(row_group(r) * 12 + mod_idx) * 1024; const float* sc = sh + 1024;
        f32x4 v[4]; float ss = 0.f;
#pragma unroll
        for (int i = 0; i < 4; ++i) { v[i] = ((const f32x4*)x)[lane + 64 * i]; ss += v[i][0] * v[i][0] + v[i][1] * v[i][1] + v[i][2] * v[i][2] + v[i][3] * v[i][3]; }
        ss = wave_sum(ss);
        const float rinv = rsqrtf(ss * (1.f / 1024.f) + EPS);
#pragma unroll
        for (int i = 0; i < 4; ++i) { const int c = 4 * (lane + 64 * i);
            const f32x4 g4 = *(const f32x4*)(gain + c), s4 = *(const f32x4*)(sc + c), h4 = *(const f32x4*)(sh + c);
            const f32x4 y = v[i] * rinv * g4 * (s4 + 1.f) + h4;
            *(u32x2*)(H + (size_t)r * 1024 + c) = (u32x2){pk2(y[0], y[1]), pk2(y[2], y[3])}; }
    }
}

__device__ __forceinline__ void p1_aux(const Params& P) {
    unsigned char* ws = P.ws;
    const float* MOD = (const float*)(ws + W_MOD);
    const int t = tid_opaque(), wave = t >> 6, lane = t & 63;
    float* RS = (float*)(ws + W_RS);
    for (int i = blockIdx.x * 512 + t; i < 5 * T; i += gridDim.x * 512) RS[i] = 0.f;
    { bf16_t* CKV = (bf16_t*)(ws + W_CKV) + (size_t)T * 256;
      for (int i = blockIdx.x * 512 + t; i < 1024 * 256 / 4; i += gridDim.x * 512) { const f32x4 v = ((const f32x4*)P.in[2])[i], k4 = *(const f32x4*)(P.in[14] + ((i * 4) & 255));
          *(u32x2*)(CKV + (size_t)i * 4) = (u32x2){pk2(v[0] / k4[0], v[1] / k4[1]), pk2(v[2] / k4[2], v[3] / k4[3])}; } }
    float* GM = (float*)(ws + W_GM);
    for (int i = blockIdx.x * 512 + t; i < 3 * 5 * 1024; i += gridDim.x * 512) { const int j = i / 5120, g = (i % 5120) >> 10, c = i & 1023;
        const float gain = (j == 0) ? P.in[10][c] : (j == 1) ? P.in[9][1024 + c] : P.in[10][1024 + c];
        const int sci = (j == 0) ? 4 : (j == 1) ? 7 : 10;
        GM[i] = gain * (1.f + MOD[(size_t)(g * 12 + sci) * 1024 + c]); }
    float* NB = (float*)(ws + W_NB);
    for (int row = blockIdx.x * 8 + wave; row < 13312; row += gridDim.x * 8) {
        const bf16_t* wt; int shi; float extra = 0.f;
        if (row < 5632) { wt = (const bf16_t*)(ws + W_WGU) + (size_t)row * 1024; shi = 3; }
        else if (row < 7680) { const int n = row - 5632, w = n & 255; wt = (const bf16_t*)(ws + W_WPW1) + (size_t)n * 1024; shi = 6; extra = P.in[23][(n >> 8) * 128 + (w & 127) + (w >= 128 ? 1024 : 0)]; }
        else { wt = (const bf16_t*)(ws + W_WGU) + (size_t)5632 * 1024 + (size_t)(row - 7680) * 1024; shi = 9; }
        const u32x4 w0 = *(const u32x4*)(wt + lane * 16), w1 = *(const u32x4*)(wt + lane * 16 + 8);
        float wf[16];
#pragma unroll
        for (int e = 0; e < 4; ++e) { wf[2 * e] = bflo(w0[e]); wf[2 * e + 1] = bfhi(w0[e]); wf[8 + 2 * e] = bflo(w1[e]); wf[8 + 2 * e + 1] = bfhi(w1[e]); }
#pragma unroll
        for (int g = 0; g < 5; ++g) { const float* sh = MOD + (size_t)(g * 12 + shi) * 1024 + lane * 16; float a = 0.f;
#pragma unroll
            for (int q = 0; q < 4; ++q) { const f32x4 v = *(const f32x4*)(sh + 4 * q); a += v[0] * wf[4 * q] + v[1] * wf[4 * q + 1] + v[2] * wf[4 * q + 2] + v[3] * wf[4 * q + 3]; }
            a = wave_sum(a);
            if (lane == 0) NB[(size_t)g * 13312 + row] = a + extra; }
    }
}

__device__ __forceinline__ void p3_postproj(const Params& P) {
    unsigned char* ws = P.ws;
    const bf16_t* PA = (const bf16_t*)(ws + W_R3); const bf16_t* PB = (const bf16_t*)((unsigned char*)P.out + OS_PB);
    bf16_t* CQN = (bf16_t*)(ws + W_CQN); bf16_t* CKVN = (bf16_t*)(ws + W_CKVN);
    const float* qa = P.in[12]; const float* kva = P.in[14];
    const int t_ = tid_opaque(), wave = t_ >> 6, lane = t_ & 63;
    constexpr int RW = 4;
    float qg[6]; { for (int i = 0; i < 3; ++i) { qg[2 * i] = qa[2 * lane + 128 * i]; qg[2 * i + 1] = qa[2 * lane + 128 * i + 1]; } }
    const f32x4 g4 = *(const f32x4*)(kva + 4 * lane);
    for (int r0 = (blockIdx.x * 8 + wave) * RW; r0 < T; r0 += gridDim.x * 8 * RW) {
        unsigned q[RW][3]; u32x2 kv[RW]; unsigned short kr[RW];
#pragma unroll
        for (int j = 0; j < RW; ++j) { const bf16_t* pa = PA + (size_t)(r0 + j) * PA_LD;
#pragma unroll
            for (int i = 0; i < 3; ++i) q[j][i] = *(const unsigned*)(pa + 2 * lane + 128 * i);
            kv[j] = *(const u32x2*)(pa + 384 + 4 * lane);
            kr[j] = (r0 < TC && lane < 32) ? PB[(size_t)(r0 + j) * PB_LD + PB_KROPE + lane] : (unsigned short)0; }
#pragma unroll
        for (int j = 0; j < RW; ++j) { const int r = r0 + j;
            float ss = 0.f;
#pragma unroll
            for (int i = 0; i < 3; ++i) { const float a = bflo(q[j][i]), b = bfhi(q[j][i]); ss += a * a + b * b; }
            const float k0 = bflo(kv[j][0]), k1 = bfhi(kv[j][0]), k2 = bflo(kv[j][1]), k3 = bfhi(kv[j][1]);
            float s2 = k0 * k0 + k1 * k1 + k2 * k2 + k3 * k3;
#pragma unroll
            for (int m = 32; m >= 1; m >>= 1) { ss += __shfl_xor(ss, m); s2 += __shfl_xor(s2, m); }
            const float rinv = rsqrtf(ss * (1.f / 384.f) + EPS), rinv2 = rsqrtf(s2 * (1.f / 256.f) + EPS);
#pragma unroll
            for (int i = 0; i < 3; ++i) *(unsigned*)(CQN + (size_t)r * 384 + 2 * lane + 128 * i) = pk2(bflo(q[j][i]) * rinv * qg[2 * i], bfhi(q[j][i]) * rinv * qg[2 * i + 1]);
            const f32x4 y = {k0 * rinv2 * g4[0], k1 * rinv2 * g4[1], k2 * rinv2 * g4[2], k3 * rinv2 * g4[3]};
            *(u32x2*)(CKVN + (size_t)r * 256 + 4 * lane) = (u32x2){pk2(y[0], y[1]), pk2(y[2], y[3])};
            if (r < TC) {
                *(f32x4*)(P.out + O_CKV + (size_t)r * 256 + 4 * lane) = y;
                if (lane < 32) P.out[O_KROPE + (size_t)r * 32 + lane] = bf2f(kr[j]);
            } }
    }
    for (int r = T + blockIdx.x * 8 + wave; r < TK; r += gridDim.x * 8) {
        const f32x4 y = *(const f32x4*)(P.in[2] + (size_t)(r - T) * 256 + 4 * lane);
        *(u32x2*)(CKVN + (size_t)r * 256 + 4 * lane) = (u32x2){pk2(y[0], y[1]), pk2(y[2], y[3])};
    }
}

__device__ __forceinline__ void rope32(float (&x)[32], const float2* rp) {
#pragma unroll
    for (int a = 0; a < 2; ++a)
#pragma unroll
        for (int i = 0; i < 8; ++i) { const float2 cs = rp[a * 8 + i]; const float x1 = x[16 * a + i], x2 = x[16 * a + 8 + i];
            x[16 * a + i] = x1 * cs.x - x2 * cs.y; x[16 * a + 8 + i] = x2 * cs.x + x1 * cs.y; }
}
__device__ __forceinline__ void p5_qknorm(const Params& P, unsigned char* smraw) {
    unsigned char* ws = P.ws;
    bf16_t* QR = (bf16_t*)(ws + W_QRAW); bf16_t* KV = (bf16_t*)(ws + W_KVRAW);
    const bf16_t* PB = (const bf16_t*)((unsigned char*)P.out + OS_PB);
    bf16_t* VTC = (bf16_t*)(ws + W_VTC); bf16_t* VTS = (bf16_t*)(ws + W_VTS);
    const float2* ROPE = (const float2*)(ws + W_ROPE);
    const float* qn = P.in[16]; const float* kn = P.in[17];
    const int t = tid_opaque();
    for (int it = blockIdx.x; it < TK / 64; it += gridDim.x) {
        const int r = it * 64 + (t >> 3), h = t & 7;
        const bool sample = (r >= TC && r < T);
        const float2* rp = ROPE + (size_t)((r - TC) & 4095) * 16;
        if (r < T) {
            u32x4* qp = (u32x4*)(QR + (size_t)r * 768 + h * 96);
            u32x4 raw[12]; float ss = 0.f;
#pragma unroll
            for (int i = 0; i < 12; ++i) { raw[i] = qp[i];
#pragma unroll
                for (int e = 0; e < 4; ++e) { const float a = bflo(raw[i][e]), b = bfhi(raw[i][e]); ss += a * a + b * b; } }
            const float rinv = rsqrtf(ss * (1.f / 96.f) + EPS), rs = rinv * QSCALE;
#pragma unroll
            for (int i = 0; i < 8; ++i) { u32x4 o;
#pragma unroll
                for (int e = 0; e < 4; ++e) o[e] = pk2(bflo(raw[i][e]) * rs * qn[i * 8 + 2 * e], bfhi(raw[i][e]) * rs * qn[i * 8 + 2 * e + 1]);
                qp[i] = o; }
            float x[32];
#pragma unroll
            for (int i = 0; i < 4; ++i)
#pragma unroll
                for (int e = 0; e < 4; ++e) { x[i * 8 + 2 * e] = bflo(raw[8 + i][e]) * rs * qn[64 + i * 8 + 2 * e]; x[i * 8 + 2 * e + 1] = bfhi(raw[8 + i][e]) * rs * qn[64 + i * 8 + 2 * e + 1]; }
            if (sample) rope32(x, rp);
#pragma unroll
            for (int i = 0; i < 4; ++i) { u32x4 o;
#pragma unroll
                for (int e = 0; e < 4; ++e) o[e] = pk2(x[i * 8 + 2 * e], x[i * 8 + 2 * e + 1]);
                qp[8 + i] = o; }
        }
        if (r < TC) {
            const bf16_t* ck = (const bf16_t*)(ws + W_CKV) + (size_t)r * 256 + h * 32;
            const float rinv = rsqrtf(((const float*)(ws + W_RS))[4 * T + r] * (1.f / 256.f) + EPS);
            float* oc = P.out + O_CKV + (size_t)r * 256 + h * 32;
#pragma unroll
            for (int i = 0; i < 4; ++i) { const u32x4 v = *(const u32x4*)(ck + i * 8); const f32x4 ka = *(const f32x4*)(P.in[14] + h * 32 + i * 8), kb = *(const f32x4*)(P.in[14] + h * 32 + i * 8 + 4);
                *(f32x4*)(oc + i * 8) = (f32x4){bflo(v[0]) * rinv * ka[0], bfhi(v[0]) * rinv * ka[1], bflo(v[1]) * rinv * ka[2], bfhi(v[1]) * rinv * ka[3]};
                *(f32x4*)(oc + i * 8 + 4) = (f32x4){bflo(v[2]) * rinv * kb[0], bfhi(v[2]) * rinv * kb[1], bflo(v[3]) * rinv * kb[2], bfhi(v[3]) * rinv * kb[3]}; }
            const u32x2 kr = *(const u32x2*)(PB + (size_t)r * PB_LD + PB_KROPE + h * 4);
            *(f32x4*)(P.out + O_KROPE + (size_t)r * 32 + h * 4) = (f32x4){bflo(kr[0]), bfhi(kr[0]), bflo(kr[1]), bfhi(kr[1])};
        }
        __builtin_amdgcn_sched_barrier(0);
        u32x4* kp = (u32x4*)(KV + (size_t)r * 1024 + h * 128);
        {
            constexpr int HS = 64 * 72 + 8;
            bf16_t* vs = (bf16_t*)smraw;
            u32x4 vv[8];
#pragma unroll
            for (int i = 0; i < 8; ++i) vv[i] = kp[8 + i];
            bf16_t* vw = vs + h * HS + (t >> 3);
#pragma unroll
            for (int i = 0; i < 8; ++i)
#pragma unroll
                for (int e = 0; e < 4; ++e) { vw[(i * 8 + 2 * e) * 72] = (bf16_t)(vv[i][e] & 0xffffu); vw[(i * 8 + 2 * e + 1) * 72] = (bf16_t)(vv[i][e] >> 16); }
            __syncthreads();
            const int rb = it * 64;
            bf16_t* vt; int lk;
            if (rb < TC) { vt = VTC + (size_t)((rb >> 8) * 8) * 64 * 256 + (rb & 255); lk = 256; }
            else if (rb < T) { const int rr = rb - TC; vt = VTS + (size_t)((rr >> 12) * 8) * 64 * LKS + 256 + (rr & 4095); lk = LKS; }
            else { const int rr = rb - T; vt = VTS + (size_t)((rr >> 8) * 8) * 64 * LKS + (rr & 255); lk = LKS; }
#pragma unroll
            for (int n = 0; n < 8; ++n) { const int vec = t + 512 * n, hd = vec >> 3, sg = vec & 7;
                const u32x4 x = *(const u32x4*)(vs + (hd >> 6) * HS + (hd & 63) * 72 + sg * 8);
                *(u32x4*)(vt + (size_t)hd * lk + sg * 8) = x; }
            __syncthreads();
        }
        __builtin_amdgcn_sched_barrier(0);
        {
            u32x4 raw[8]; float x[32]; float ss = 0.f;
#pragma unroll
            for (int i = 0; i < 8; ++i) { raw[i] = kp[i];
#pragma unroll
                for (int e = 0; e < 4; ++e) { const float a = bflo(raw[i][e]), b = bfhi(raw[i][e]); ss += a * a + b * b; } }
            if (r < T) {
                const u32x4* pp = (const u32x4*)(PB + (size_t)r * PB_LD + PB_KROPE);
#pragma unroll
                for (int i = 0; i < 4; ++i) { const u32x4 v = pp[i];
#pragma unroll
                    for (int e = 0; e < 4; ++e) { x[i * 8 + 2 * e] = bflo(v[e]); x[i * 8 + 2 * e + 1] = bfhi(v[e]); } }
            } else {
                const f32x4* pp = (const f32x4*)(P.in[3] + (size_t)(r - T) * 32);
#pragma unroll
                for (int i = 0; i < 8; ++i) { const f32x4 v = pp[i];
#pragma unroll
                    for (int e = 0; e < 4; ++e) x[i * 4 + e] = v[e]; }
            }
#pragma unroll
            for (int d = 0; d < 32; ++d) ss += x[d] * x[d];
            const float rinv = rsqrtf(ss * (1.f / 96.f) + EPS);
#pragma unroll
            for (int i = 0; i < 8; ++i) { u32x4 o;
#pragma unroll
                for (int e = 0; e < 4; ++e) o[e] = pk2(bflo(raw[i][e]) * rinv * kn[i * 8 + 2 * e], bfhi(raw[i][e]) * rinv * kn[i * 8 + 2 * e + 1]);
                kp[i] = o; }
#pragma unroll
            for (int d = 0; d < 32; ++d) x[d] = x[d] * rinv * kn[64 + d];
            if (sample) rope32(x, rp);
#pragma unroll
            for (int i = 0; i < 4; ++i) { u32x4 o;
#pragma unroll
                for (int e = 0; e < 4; ++e) o[e] = pk2(x[i * 8 + 2 * e], x[i * 8 + 2 * e + 1]);
                kp[8 + i] = o; }
        }
    }
}

constexpr int GL_GA = 0;
constexpr int GL_SEG = GL_GA + 64 * 32 * 4;
constexpr int GL_QR = GL_SEG + 8 * 64 * 4;
constexpr int GL_KR = GL_QR + 64 * 72 * 2;
constexpr int GL_QS = GL_KR + 64 * 72 * 2;
constexpr int GL_KS = GL_QS + 64 * 72 * 2;
constexpr int GL_SC = GL_KS + 64 * 72 * 2;
constexpr int GL_VT = GL_SC + 64 * 72 * 2;
constexpr int GL_ST = GL_VT + 128 * 72 * 2;
constexpr int GL_END = GL_ST + 2 * 128 * 72 * 2;
static_assert(GL_END <= 128 * 1024 && 64 * 132 * 4 <= 2 * 128 * 72 * 2, "GLA LDS");

__device__ __forceinline__ void gla_load_w(const Params& P, int h, int d, float (&w)[2][16], float (&bb)[2]) {
#pragma unroll
    for (int dir = 0; dir < 2; ++dir) {
#pragma unroll
        for (int r = 0; r < 16; ++r) w[dir][r] = P.in[18][(size_t)dir * 4096 + r * 256 + h * 64 + d];
        bb[dir] = P.in[19][dir * 256 + h * 64 + d]; }
}
__device__ __forceinline__ void gla_cum(const float (&w)[16], float b, int dir, unsigned char* sm, int d, int seg, float (&cum)[8], float& last) {
    const float* gaL = (const float*)(sm + GL_GA); float* segL = (float*)(sm + GL_SEG);
    float la[8];
#pragma unroll
    for (int ii = 0; ii < 8; ii += 2) { f32x2_t z = {b, b}; const float* g0 = gaL + (seg * 8 + ii) * 32 + dir * 16; const float* g1 = g0 + 32;
#pragma unroll
        for (int r = 0; r < 16; ++r) z = __builtin_elementwise_fma((f32x2_t){g0[r], g1[r]}, (f32x2_t){w[r], w[r]}, z);
        la[ii] = (fminf(z[0], 0.f) - __logf(1.f + __expf(-fabsf(z[0])))) * (1.f / 16.f);
        la[ii + 1] = (fminf(z[1], 0.f) - __logf(1.f + __expf(-fabsf(z[1])))) * (1.f / 16.f); }
    if (dir == 0) { cum[0] = la[0];
#pragma unroll
        for (int ii = 1; ii < 8; ++ii) cum[ii] = cum[ii - 1] + la[ii];
        segL[seg * 64 + d] = cum[7]; }
    else { cum[7] = la[7];
#pragma unroll
        for (int ii = 6; ii >= 0; --ii) cum[ii] = cum[ii + 1] + la[ii];
        segL[seg * 64 + d] = cum[0]; }
    __syncthreads();
    float off = 0.f, tot = 0.f;
#pragma unroll
    for (int s = 0; s < 8; ++s) { const float v = segL[s * 64 + d]; tot += v; if (dir == 0 ? (s < seg) : (s > seg)) off += v; }
#pragma unroll
    for (int ii = 0; ii < 8; ++ii) cum[ii] += off;
    last = tot;
}
__device__ __forceinline__ f32x16 mfma32(bf16x8 a, bf16x8 b, f32x16 c) { return __builtin_amdgcn_mfma_f32_32x32x16_bf16(a, b, c, 0, 0, 0); }
__device__ __forceinline__ f32x16 tile_mm64(const bf16_t* A, int m0, const bf16_t* Bt, int n0, f32x16 acc, int lane) {
    const int rr = lane & 31, hh = lane >> 5;
#pragma unroll
    for (int ks = 0; ks < 4; ++ks) { const bf16x8 a = *(const bf16x8*)(A + (m0 + rr) * 72 + ks * 16 + 8 * hh), b = *(const bf16x8*)(Bt + (n0 + rr) * 72 + ks * 16 + 8 * hh); acc = mfma32(a, b, acc); }
    return acc;
}
#define GLA_LD_GA(row0) (*(const u32x4*)(PB + (size_t)((row0) + (t >> 2)) * PB_LD + PB_GA + (t & 3) * 8))
#define GLA_LD_V(row0, n) (*(const u32x4*)(PB + (size_t)((row0) + ((t + 512 * (n)) >> 4)) * PB_LD + PB_GV + h * 128 + ((t + 512 * (n)) & 15) * 8))
#define GLA_LD_QK(row0, off) (*(const u32x4*)(PB + (size_t)((row0) + (t >> 3)) * PB_LD + (off) + h * 64 + (t & 7) * 8))
__device__ __forceinline__ void gla_stage_ga(unsigned char* sm, u32x4 r, int t) {
    if (t < 256) { float* g = (float*)(sm + GL_GA) + (t >> 2) * 32 + (t & 3) * 8;
        *(f32x4*)g = (f32x4){bflo(r[0]), bfhi(r[0]), bflo(r[1]), bfhi(r[1])}; *(f32x4*)(g + 4) = (f32x4){bflo(r[2]), bfhi(r[2]), bflo(r[3]), bfhi(r[3])}; }
}
#define GLA_LD_V16(row0, arr) do { const bf16_t* vp_ = PB + (size_t)((row0) + (t >> 7) * 16) * PB_LD + PB_GV + h * 128 + (t & 127); \
        _Pragma("unroll") for (int jj_ = 0; jj_ < 16; ++jj_) arr[jj_] = vp_[(size_t)jj_ * PB_LD]; } while (0)
__device__ __forceinline__ void gla_stage_v16(unsigned char* sm, const bf16_t (&a)[16], int t) {
    bf16_t* vT = (bf16_t*)(sm + GL_VT) + (t & 127) * 72 + (t >> 7) * 16;
    *(u32x4*)vT = (u32x4){(unsigned)a[0] | ((unsigned)a[1] << 16), (unsigned)a[2] | ((unsigned)a[3] << 16), (unsigned)a[4] | ((unsigned)a[5] << 16), (unsigned)a[6] | ((unsigned)a[7] << 16)};
    *(u32x4*)(vT + 8) = (u32x4){(unsigned)a[8] | ((unsigned)a[9] << 16), (unsigned)a[10] | ((unsigned)a[11] << 16), (unsigned)a[12] | ((unsigned)a[13] << 16), (unsigned)a[14] | ((unsigned)a[15] << 16)};
}
__device__ __forceinline__ void gla_stage_vT(unsigned char* sm, u32x4 r, int p) {
    bf16_t* vT = (bf16_t*)(sm + GL_VT) + (p & 15) * 8 * 72 + (p >> 4);
#pragma unroll
    for (int e = 0; e < 4; ++e) { vT[(2 * e) * 72] = (bf16_t)(r[e] & 0xffffu); vT[(2 * e + 1) * 72] = (bf16_t)(r[e] >> 16); }
}

__device__ __forceinline__ void gla_pass1(const Params& P, unsigned char* sm) {
    const bf16_t* PB = (const bf16_t*)((unsigned char*)P.out + OS_PB);
    bf16_t* DS = (bf16_t*)(P.ws + W_DS); float* E = (float*)((unsigned char*)P.out + OS_E);
    const int t = tid_opaque(), lane = t & 63, wv = t >> 6, d = t & 63, seg = t >> 6;
    bf16_t* kT = (bf16_t*)(sm + GL_KS); const bf16_t* vT = (const bf16_t*)(sm + GL_VT); const bf16_t* kr = (const bf16_t*)(sm + GL_KR);
    int hw = -1; float w[2][16], bb[2];
    for (int item = blockIdx.x; item < 1536; item += gridDim.x) {
        const int cgk = item >> 2, h = item & 3, row0 = cgk * 64;
        if (h != hw) { gla_load_w(P, h, d, w, bb); hw = h; }
        { u32x4 rga = {0u, 0u, 0u, 0u}; if (t < 256) rga = GLA_LD_GA(row0); const u32x4 rk = GLA_LD_QK(row0, PB_GK); bf16_t rv[16]; GLA_LD_V16(row0, rv);
          gla_stage_ga(sm, rga, t); gla_stage_v16(sm, rv, t);
          *(u32x4*)(sm + GL_KR + ((t >> 3) * 72 + (t & 7) * 8) * 2) = rk; }
        __syncthreads();
        for (int dir = 0; dir < 2; ++dir) {
            float cum[8], last;
            gla_cum(w[dir], bb[dir], dir, sm, d, seg, cum, last);
            unsigned pk[4];
#pragma unroll
            for (int jj = 0; jj < 4; ++jj) {
                const float k0 = bf2f(kr[(seg * 8 + 2 * jj) * 72 + d]) * __expf(last - cum[2 * jj]);
                const float k1 = bf2f(kr[(seg * 8 + 2 * jj + 1) * 72 + d]) * __expf(last - cum[2 * jj + 1]);
                pk[jj] = pk2(k0, k1); }
            *(u32x4*)(kT + d * 72 + seg * 8) = (u32x4){pk[0], pk[1], pk[2], pk[3]};
            if (seg == 0) E[(size_t)(item * 2 + dir) * 64 + d] = __expf(last);
            __syncthreads();
            const int mt = wv >> 1, nt = wv & 1;
            f32x16 acc;
#pragma unroll
            for (int i = 0; i < 16; ++i) acc[i] = 0.f;
            acc = tile_mm64(vT, mt * 32, kT, nt * 32, acc, lane);
            bf16_t* o = DS + (size_t)(item * 2 + dir) * 8192 + nt * 32 + (lane & 31);
#pragma unroll
            for (int i = 0; i < 16; ++i) o[(size_t)(mt * 32 + (i & 3) + 8 * (i >> 2) + 4 * (lane >> 5)) * 64] = f2bf(acc[i]);
            __syncthreads();
        }
    }
}

template <int NC, int BATCH>
__device__ __forceinline__ void gla_scan_chain(bf16_t* DS, const float* E, int cg0, int h, int dir, int e, float s0, float s1, float* fin) {
    const int dk = e & 63, dv = e >> 6;
    for (int st0 = 0; st0 < NC; st0 += BATCH) {
        unsigned ds[BATCH]; float2 ee[BATCH];
#pragma unroll
        for (int i = 0; i < BATCH; ++i) { const int st = st0 + i, c = dir == 0 ? st : NC - 1 - st; const size_t idx = (size_t)((cg0 + c) * 4 + h) * 2 + dir;
            ds[i] = *(const unsigned*)(DS + idx * 8192 + e); ee[i] = *(const float2*)(E + idx * 64 + dk); }
#pragma unroll
        for (int i = 0; i < BATCH; ++i) { const int st = st0 + i, c = dir == 0 ? st : NC - 1 - st; const size_t idx = (size_t)((cg0 + c) * 4 + h) * 2 + dir;
            *(unsigned*)(DS + idx * 8192 + e) = pk2(s0, s1);
            s0 = ee[i].x * s0 + bflo(ds[i]); s1 = ee[i].y * s1 + bfhi(ds[i]); }
    }
    if (fin) { fin[dk * 128 + dv] = s0; fin[(dk + 1) * 128 + dv] = s1; }
}
__device__ __forceinline__ void gla_pass2(const Params& P) {
    bf16_t* DS = (bf16_t*)(P.ws + W_DS); const float* E = (const float*)((unsigned char*)P.out + OS_E);
    const int t = tid_opaque();
    for (int it = blockIdx.x; it < 256; it += gridDim.x) {
        if (it < 256) { const int part = it & 7, dir = (it >> 3) & 1, h = (it >> 4) & 3, b = it >> 6, e = (part * 512 + t) * 2;
            const float* s0p = P.in[4] + (size_t)((b * 2 + dir) * 4 + h) * 8192 + (e & 63) * 128 + (e >> 6);
            gla_scan_chain<64, 16>(DS, E, 128 + b * 64, h, dir, e, s0p[0], s0p[128], nullptr);
        } else { const int i2 = it - 256, part = i2 & 7, dir = (i2 >> 3) & 1, h = (i2 >> 4) & 3, b = i2 >> 6, e = (part * 512 + t) * 2;
            gla_scan_chain<4, 4>(DS, E, b * 4, h, dir, e, 0.f, 0.f, P.out + O_STATE + (size_t)((b * 2 + dir) * 4 + h) * 8192);
        }
    }
    for (int it0 = blockIdx.x * 4; it0 < 2048; it0 += gridDim.x * 4) {
        unsigned ds[4][4]; float2 ee[4][4];
#pragma unroll
        for (int q = 0; q < 4; ++q) { const int i2 = it0 + q, part = i2 & 7, dir = (i2 >> 3) & 1, h = (i2 >> 4) & 3, b = i2 >> 6, e = (part * 512 + t) * 2;
#pragma unroll
            for (int st = 0; st < 4; ++st) { const int c = dir == 0 ? st : 3 - st; const size_t idx = (size_t)((b * 4 + c) * 4 + h) * 2 + dir;
                ds[q][st] = *(const unsigned*)(DS + idx * 8192 + e); ee[q][st] = *(const float2*)(E + idx * 64 + (e & 63)); } }
#pragma unroll
        for (int q = 0; q < 4; ++q) { const int i2 = it0 + q, part = i2 & 7, dir = (i2 >> 3) & 1, h = (i2 >> 4) & 3, b = i2 >> 6, e = (part * 512 + t) * 2;
            float s0 = 0.f, s1 = 0.f;
#pragma unroll
            for (int st = 0; st < 4; ++st) { const int c = dir == 0 ? st : 3 - st; const size_t idx = (size_t)((b * 4 + c) * 4 + h) * 2 + dir;
                *(unsigned*)(DS + idx * 8192 + e) = pk2(s0, s1);
                s0 = ee[q][st].x * s0 + bflo(ds[q][st]); s1 = ee[q][st].y * s1 + bfhi(ds[q][st]); }
            float* fin = P.out + O_STATE + (size_t)((b * 2 + dir) * 4 + h) * 8192;
            fin[(e & 63) * 128 + (e >> 6)] = s0; fin[((e & 63) + 1) * 128 + (e >> 6)] = s1; }
    }
}

__device__ __forceinline__ void gla_pass3(const Params& P, unsigned char* sm) {
    const bf16_t* PB = (const bf16_t*)((unsigned char*)P.out + OS_PB);
    const bf16_t* SP = (const bf16_t*)(P.ws + W_DS);
    bf16_t* ATT = (bf16_t*)(P.ws + W_R1);
    const float* gn = P.in[20];
    const int t = tid_opaque(), lane = t & 63, wv = t >> 6, d = t & 63, seg = t >> 6;
    const bf16_t* qr = (const bf16_t*)(sm + GL_QR); const bf16_t* kr = (const bf16_t*)(sm + GL_KR);
    bf16_t* qs = (bf16_t*)(sm + GL_QS); bf16_t* ks = (bf16_t*)(sm + GL_KS); bf16_t* sc = (bf16_t*)(sm + GL_SC);
    const bf16_t* vT = (const bf16_t*)(sm + GL_VT); bf16_t* ST = (bf16_t*)(sm + GL_ST); float* ob = (float*)(sm + GL_ST);
    int hw = -1; float w[2][16], bb[2];
    u32x4 rga = {0u, 0u, 0u, 0u}, rq, rk, rs00, rs01, rs10, rs11, rg0, rg1; bf16_t rv[16];
#define G3_LOAD(it_) do { const int h = (it_) & 3, row0_ = ((it_) >> 2) * 64; \
        if (t < 256) rga = GLA_LD_GA(row0_); GLA_LD_V16(row0_, rv); rq = GLA_LD_QK(row0_, PB_GQ); rk = GLA_LD_QK(row0_, PB_GK); \
        const bf16_t* sp_ = SP + (size_t)((it_) * 2) * 8192 + (size_t)t * 8; rs00 = *(const u32x4*)sp_; rs01 = *(const u32x4*)(sp_ + 4096); rs10 = *(const u32x4*)(sp_ + 8192); rs11 = *(const u32x4*)(sp_ + 8192 + 4096); \
        const bf16_t* gp_ = PB + (size_t)(row0_ + (t >> 3)) * PB_LD + PB_GG + h * 128 + (t & 7) * 16; rg0 = *(const u32x4*)gp_; rg1 = *(const u32x4*)(gp_ + 8); } while (0)
    int item = blockIdx.x;
    if (item < 1536) G3_LOAD(item);
    for (; item < 1536; item += gridDim.x) {
        const int cgk = item >> 2, h = item & 3, row0 = cgk * 64;
        if (h != hw) { gla_load_w(P, h, d, w, bb); hw = h; }
        gla_stage_ga(sm, rga, t); gla_stage_v16(sm, rv, t);
        *(u32x4*)(sm + GL_QR + ((t >> 3) * 72 + (t & 7) * 8) * 2) = rq;
        *(u32x4*)(sm + GL_KR + ((t >> 3) * 72 + (t & 7) * 8) * 2) = rk;
        *(u32x4*)(ST + (t >> 3) * 72 + (t & 7) * 8) = rs00; *(u32x4*)(ST + (64 + (t >> 3)) * 72 + (t & 7) * 8) = rs01;
        *(u32x4*)(ST + 128 * 72 + (t >> 3) * 72 + (t & 7) * 8) = rs10; *(u32x4*)(ST + 128 * 72 + (64 + (t >> 3)) * 72 + (t & 7) * 8) = rs11;
        const u32x4 g0 = rg0, g1 = rg1;
        __syncthreads();
        if (item + (int)gridDim.x < 1536) G3_LOAD(item + (int)gridDim.x);
        f32x16 oacc;
#pragma unroll
        for (int i = 0; i < 16; ++i) oacc[i] = 0.f;
        for (int dir = 0; dir < 2; ++dir) {
            float cum[8], last;
            gla_cum(w[dir], bb[dir], dir, sm, d, seg, cum, last);
#pragma unroll
            for (int ii = 0; ii < 8; ++ii) { const int o_ = (seg * 8 + ii) * 72 + d;
                qs[o_] = f2bf(bf2f(qr[o_]) * 0.125f * __expf(cum[ii]));
                ks[o_] = f2bf(bf2f(kr[o_]) * __expf(-cum[ii])); }
            __syncthreads();
            if (wv < 4) { const int mt = wv >> 1, nt = wv & 1;
                f32x16 s_;
#pragma unroll
                for (int i = 0; i < 16; ++i) s_[i] = 0.f;
                s_ = tile_mm64(qs, mt * 32, ks, nt * 32, s_, lane);
                const int j = nt * 32 + (lane & 31);
#pragma unroll
                for (int i = 0; i < 16; ++i) { const int ir = mt * 32 + (i & 3) + 8 * (i >> 2) + 4 * (lane >> 5);
                    const bool keep = dir == 0 ? (j <= ir) : (j >= ir);
                    sc[ir * 72 + j] = f2bf(keep ? s_[i] : 0.f); } }
            if (wv >= 4) oacc = tile_mm64(qs, (wv >> 2) * 32, ST + dir * 128 * 72, (wv & 3) * 32, oacc, lane);
            __syncthreads();
            { const int mt = wv >> 2, nt = wv & 3;
              oacc = tile_mm64(sc, mt * 32, vT, nt * 32, oacc, lane);
              if (wv < 4) oacc = tile_mm64(qs, mt * 32, ST + dir * 128 * 72, nt * 32, oacc, lane); }
            __syncthreads();
        }
        { const int mt = wv >> 2, nt = wv & 3;
#pragma unroll
          for (int i = 0; i < 16; ++i) ob[(mt * 32 + (i & 3) + 8 * (i >> 2) + 4 * (lane >> 5)) * 132 + nt * 32 + (lane & 31)] = oacc[i]; }
        __syncthreads();
        { const int i = t >> 3, sub = t & 7; float v[16]; float ss = 0.f;
#pragma unroll
          for (int c = 0; c < 16; ++c) { v[c] = ob[i * 132 + sub * 16 + c]; ss += v[c] * v[c]; }
          ss += __shfl_xor(ss, 1); ss += __shfl_xor(ss, 2); ss += __shfl_xor(ss, 4);
          const float rinv = rsqrtf(ss * (1.f / 128.f) + EPS);
          unsigned o[8];
#pragma unroll
          for (int c = 0; c < 8; ++c) { const unsigned gw = c < 4 ? g0[c & 3] : g1[c & 3]; const float ga = bflo(gw), gb = bfhi(gw);
              const float y0 = v[2 * c] * rinv * gn[sub * 16 + 2 * c] * ga * sigmoidf_(ga), y1 = v[2 * c + 1] * rinv * gn[sub * 16 + 2 * c + 1] * gb * sigmoidf_(gb);
              o[c] = pk2(y0, y1); }
          u32x4* op = (u32x4*)(ATT + (size_t)(row0 + i) * 1024 + 512 + h * 128 + sub * 16);
          op[0] = (u32x4){o[0], o[1], o[2], o[3]}; op[1] = (u32x4){o[4], o[5], o[6], o[7]}; }
        __syncthreads();
    }
#undef G3_LOAD
}

constexpr int AT_KS = 0;
constexpr int AT_VS = AT_KS + 2 * 64 * 104 * 2;
template <int QT>
__device__ __forceinline__ void attn_item(const bf16_t* Q, const bf16_t* KV, const bf16_t* vt, bf16_t* ATT, bf16_t* Ks, bf16_t* Vs,
                                          int h, int q0, int nkt, int lk, int krow_a, int krow_b, float negCB, int t) {
    const int lane = t & 63, wv = t >> 6, rr = lane & 31, hh = lane >> 5;
    const int kkey0 = t / 12, kseg0 = t % 12, kkey1 = (512 + t) / 12, kseg1 = (512 + t) % 12, vdv = t >> 3, vseg = t & 7;
    u32x4 kr0, kr1 = {0u, 0u, 0u, 0u}, vr;
#define AT_LOAD(kt) do { const int kb = ((kt) < 4 ? krow_a + (kt) * 64 : krow_b + ((kt) - 4) * 64); \
        kr0 = *(const u32x4*)(KV + (size_t)(kb + kkey0) * 1024 + h * 128 + kseg0 * 8); \
        if (t < 256) kr1 = *(const u32x4*)(KV + (size_t)(kb + kkey1) * 1024 + h * 128 + kseg1 * 8); \
        vr = *(const u32x4*)(vt + (size_t)vdv * lk + (kt) * 64 + vseg * 8); } while (0)
    AT_LOAD(0);
    bf16x8 qf[QT][6];
#pragma unroll
    for (int qt = 0; qt < QT; ++qt) { const bf16_t* qp = Q + (size_t)(q0 + (wv * QT + qt) * 32 + rr) * 768 + h * 96 + 8 * hh;
#pragma unroll
        for (int ks = 0; ks < 6; ++ks) qf[qt][ks] = *(const bf16x8*)(qp + ks * 16); }
    f32x16 O[QT][2];
    float lsum[QT];
#pragma unroll
    for (int qt = 0; qt < QT; ++qt) { lsum[qt] = 0.f;
#pragma unroll
        for (int i = 0; i < 16; ++i) { O[qt][0][i] = 0.f; O[qt][1][i] = 0.f; } }
    for (int kt = 0; kt < nkt; ++kt) {
        bf16_t* Kb = Ks + (kt & 1) * 64 * 104; bf16_t* Vb = Vs + (kt & 1) * 64 * 72;
        *(u32x4*)(Kb + kkey0 * 104 + kseg0 * 8) = kr0;
        if (t < 256) *(u32x4*)(Kb + kkey1 * 104 + kseg1 * 8) = kr1;
        *(u32x4*)(Vb + vdv * 72 + vseg * 8) = vr;
        __syncthreads();
        if (kt + 1 < nkt) AT_LOAD(kt + 1);
#pragma unroll 1
        for (int sub = 0; sub < 2; ++sub) {
            f32x16 s[QT];
#pragma unroll
            for (int qt = 0; qt < QT; ++qt)
#pragma unroll
                for (int i = 0; i < 16; ++i) s[qt][i] = negCB;
#pragma unroll
            for (int ks = 0; ks < 6; ++ks) { const bf16x8 a = *(const bf16x8*)(Kb + (sub * 32 + rr) * 104 + ks * 16 + 8 * hh);
#pragma unroll
                for (int qt = 0; qt < QT; ++qt) s[qt] = mfma32(a, qf[qt][ks], s[qt]); }
            bf16x8 pb[QT][2];
#pragma unroll
            for (int qt = 0; qt < QT; ++qt) {
#pragma unroll
                for (int i = 0; i < 16; ++i) { s[qt][i] = __builtin_amdgcn_exp2f(s[qt][i]); lsum[qt] += s[qt][i]; }
                const u32x4 p0 = {pk2(s[qt][0], s[qt][1]), pk2(s[qt][2], s[qt][3]), pk2(s[qt][4], s[qt][5]), pk2(s[qt][6], s[qt][7])};
                const u32x4 p1 = {pk2(s[qt][8], s[qt][9]), pk2(s[qt][10], s[qt][11]), pk2(s[qt][12], s[qt][13]), pk2(s[qt][14], s[qt][15])};
                pb[qt][0] = __builtin_bit_cast(bf16x8, p0); pb[qt][1] = __builtin_bit_cast(bf16x8, p1); }
#pragma unroll
            for (int j = 0; j < 2; ++j)
#pragma unroll
                for (int dvt = 0; dvt < 2; ++dvt) {
                    const u32x2 a0 = *(const u32x2*)(Vb + (dvt * 32 + rr) * 72 + sub * 32 + 16 * j + 4 * hh), a1 = *(const u32x2*)(Vb + (dvt * 32 + rr) * 72 + sub * 32 + 16 * j + 8 + 4 * hh);
                    const u32x4 av = {a0[0], a0[1], a1[0], a1[1]};
                    const bf16x8 a = __builtin_bit_cast(bf16x8, av);
#pragma unroll
                    for (int qt = 0; qt < QT; ++qt) O[qt][dvt] = mfma32(a, pb[qt][j], O[qt][dvt]);
                }
        }
    }
#undef AT_LOAD
#pragma unroll
    for (int qt = 0; qt < QT; ++qt) {
        float l = lsum[qt]; l += __shfl_xor(l, 32);
        const float inv = 1.f / l;
        bf16_t* op = ATT + (size_t)(q0 + (wv * QT + qt) * 32 + rr) * 1024 + h * 64 + 4 * hh;
#pragma unroll
        for (int g = 0; g < 4; ++g) {
            *(u32x2*)(op + 8 * g) = (u32x2){pk2(O[qt][0][4 * g] * inv, O[qt][0][4 * g + 1] * inv), pk2(O[qt][0][4 * g + 2] * inv, O[qt][0][4 * g + 3] * inv)};
            *(u32x2*)(op + 32 + 8 * g) = (u32x2){pk2(O[qt][1][4 * g] * inv, O[qt][1][4 * g + 1] * inv), pk2(O[qt][1][4 * g + 2] * inv, O[qt][1][4 * g + 3] * inv)};
        }
    }
    __syncthreads();
}
__device__ __forceinline__ void attn_phase(const Params& P, unsigned char* sm) {
    unsigned char* ws = P.ws;
    const bf16_t* Q = (const bf16_t*)(ws + W_QRAW); const bf16_t* KV = (const bf16_t*)(ws + W_KVRAW);
    const bf16_t* VTC = (const bf16_t*)(ws + W_VTC); const bf16_t* VTS = (const bf16_t*)(ws + W_VTS);
    bf16_t* ATT = (bf16_t*)(ws + W_R1);
    const int t = tid_opaque();
    bf16_t* Ks = (bf16_t*)(sm + AT_KS); bf16_t* Vs = (bf16_t*)(sm + AT_VS);
    float negCB;
    { float mq = 0.f, mk = 0.f;
      for (int d = 0; d < 96; ++d) { mq = fmaxf(mq, fabsf(P.in[16][d])); mk = fmaxf(mk, fabsf(P.in[17][d])); }
      negCB = -1.02f * 96.f * mq * mk * QSCALE; }
    for (int item0 = blockIdx.x; item0 < 256; item0 += gridDim.x) {
        const int item = (gridDim.x == 256) ? (item0 & 7) * 32 + (item0 >> 3) : item0;
        const int qb = item & 7, h = (item >> 3) & 7, b = item >> 6;
        attn_item<2>(Q, KV, VTS + (size_t)(b * 8 + h) * 64 * LKS, ATT, Ks, Vs, h, TC + b * 4096 + qb * 512, 68, LKS, T + b * 256, TC + b * 4096, negCB, t);
    }
    for (int item = blockIdx.x; item < 256; item += gridDim.x) {
        const int h = item & 7, b = item >> 3;
        attn_item<1>(Q, KV, VTC + (size_t)(b * 8 + h) * 64 * 256, ATT, Ks, Vs, h, b * 256, 4, 256, b * 256, 0, negCB, t);
    }
}

__device__ __forceinline__ void dwconv_phase(const Params& P, unsigned char* smraw) {
    const bf16_t* U = (const bf16_t*)(P.ws + W_R1); bf16_t* U2 = (bf16_t*)(P.ws + W_R1 + (size_t)T * 1024 * 2);
    float* red = (float*)smraw;
    const int t = tid_opaque(), lane = t & 63, wv = t >> 6, c = 2 * t;
    float* wl = (float*)(smraw + 1024);
    for (int i = t; i < 31 * 1024 / 4; i += 512) ((f32x4*)wl)[i] = ((const f32x4*)P.in[24])[i];
    __syncthreads();
    const float2 bdw = *(const float2*)(P.in[25] + c), lg = *(const float2*)(P.in[26] + c), lb = *(const float2*)(P.in[27] + c);
    const int rows_per = (T / 8 + (int)gridDim.x - 1) / (int)gridDim.x * 8;
    const int R0 = blockIdx.x * rows_per, R1 = (R0 + rows_per < T) ? R0 + rows_per : T;
    unsigned win[38], nxt[8];
#pragma unroll
    for (int k = 0; k < 38; ++k) { const int r = R0 - 15 + k; win[k] = 0u; if (r >= 0 && r < T) win[k] = *(const unsigned*)(U + (size_t)r * 1024 + c); }
    int par = 0;
    for (int r0 = R0; r0 < R1; r0 += 8, par ^= 1) {
        int s0, s1;
        if (r0 < TC) { s0 = r0 & ~255; s1 = s0 + 256; } else { s0 = TC + ((r0 - TC) & ~4095); s1 = s0 + 4096; }
#pragma unroll
        for (int k = 0; k < 8; ++k) { const int r = r0 + 23 + k; nxt[k] = 0u; if (r < T) nxt[k] = *(const unsigned*)(U + (size_t)r * 1024 + c); }
        float a0[8], a1[8];
#pragma unroll
        for (int o = 0; o < 8; ++o) { a0[o] = bdw.x; a1[o] = bdw.y; }
        float x0[38], x1[38];
#pragma unroll
        for (int k = 0; k < 38; ++k) { const int r = r0 - 15 + k; const bool ok = (r >= s0 && r < s1); x0[k] = ok ? bflo(win[k]) : 0.f; x1[k] = ok ? bfhi(win[k]) : 0.f; }
#pragma unroll
        for (int j = 0; j < 31; ++j) { const float2 w = *(const float2*)(wl + j * 1024 + c);
#pragma unroll
            for (int o = 0; o < 8; ++o) { a0[o] += x0[o + j] * w.x; a1[o] += x1[o + j] * w.y; } }
        float* rd = red + par * 128;
#pragma unroll
        for (int o = 0; o < 8; ++o) { const float s1_ = wave_sum(a0[o] + a1[o]), s2_ = wave_sum(a0[o] * a0[o] + a1[o] * a1[o]);
            if (lane == 0) { rd[wv * 16 + o] = s1_; rd[wv * 16 + 8 + o] = s2_; } }
        __syncthreads();
#pragma unroll
        for (int o = 0; o < 8; ++o) { float m = 0.f, v = 0.f;
#pragma unroll
            for (int w = 0; w < 8; ++w) { m += rd[w * 16 + o]; v += rd[w * 16 + 8 + o]; }
            m *= (1.f / 1024.f); v = v * (1.f / 1024.f) - m * m;
            const float rinv = rsqrtf(fmaxf(v, 0.f) + EPS);
            const float y0 = (a0[o] - m) * rinv * lg.x + lb.x, y1 = (a1[o] - m) * rinv * lg.y + lb.y;
            *(unsigned*)(U2 + (size_t)(r0 + o) * 1024 + c) = pk2(y0 * sigmoidf_(y0), y1 * sigmoidf_(y1)); }
#pragma unroll
        for (int k = 0; k < 30; ++k) win[k] = win[k + 8];
#pragma unroll
        for (int k = 0; k < 8; ++k) win[30 + k] = nxt[k];
    }
    __syncthreads();
}

#define XB_TMO      128
#define XB_XCNT(j)  (256  + 64 * (j))
#define XB_XSUB(j)  (1280 + 64 * (j))
#define XB_XGEN(j)  (2304 + 64 * (j))
#define XB_TOP      3328
#define XB_TOPGEN   3392
#define XCD_BAR_WORDS 3456
static_assert(XCD_BAR_WORDS * 4 <= 16384, "barrier words");
#define XB_SPIN_CAP (1u << 18)

__device__ __forceinline__ unsigned xb_ld(unsigned* p)              { return __hip_atomic_load(p, __ATOMIC_RELAXED, __HIP_MEMORY_SCOPE_AGENT); }
__device__ __forceinline__ unsigned xb_add(unsigned* p, unsigned v) { return __hip_atomic_fetch_add(p, v, __ATOMIC_RELAXED, __HIP_MEMORY_SCOPE_AGENT); }
__device__ __forceinline__ unsigned xb_xcc_id() { return (unsigned)__builtin_amdgcn_s_getreg((3 << 11) | 20) & 0xFu; }
#define XB_SPIN(cond, bar) do { unsigned _sp = 0; while (cond) { __builtin_amdgcn_s_sleep(1); \
    if ((++_sp & 255u) == 0u) { if (xb_ld(&(bar)[XB_TMO])) break; if (_sp > XB_SPIN_CAP) { atomicAdd(&(bar)[XB_TMO], 1u); break; } } } } while (0)

struct XcdBarrier {
    unsigned* bar; unsigned x;
    volatile LAS unsigned* st;
};

__device__ __forceinline__ XcdBarrier xcd_barrier_post(unsigned* bar, volatile LAS unsigned* st) {
    XcdBarrier b; b.bar = bar; b.x = xb_xcc_id(); b.st = st;
    if (threadIdx.x == 0) (void)xb_add(&bar[XB_XCNT(b.x)], 1u);
    return b;
}
__device__ __forceinline__ void xcd_barrier_complete(unsigned* bar, unsigned x, unsigned& nloc, unsigned& nx) {
    const unsigned G = gridDim.x * gridDim.y * gridDim.z;
    unsigned sum, cnt, mine, sp = 0u;
    for (;;) {
        sum = 0u; cnt = 0u; mine = 0u;
#pragma unroll
        for (unsigned j = 0; j < 16; ++j) { const unsigned c = xb_ld(&bar[XB_XCNT(j)]); sum += c; cnt += (c > 0u) ? 1u : 0u; mine = (j == x) ? c : mine; }
        if (sum == G) break;
        __builtin_amdgcn_s_sleep(1);
        if ((++sp & 255u) == 0u) { if (xb_ld(&bar[XB_TMO])) break; if (sp > XB_SPIN_CAP) { atomicAdd(&bar[XB_TMO], 1u); break; } }
    }
    nloc = mine > 0u ? mine : 1u; nx = cnt > 0u ? cnt : 1u;
}

__device__ __forceinline__ void xcd_barrier(const XcdBarrier& b) {
    asm volatile("s_waitcnt vmcnt(0)" ::: "memory");
    __syncthreads();
    if (threadIdx.x == 0) {
        unsigned* bar = b.bar;
        __builtin_amdgcn_s_waitcnt(0);
        unsigned nloc = b.st[0], nx = b.st[1];
        if (nloc == 0u) { xcd_barrier_complete(bar, b.x, nloc, nx); b.st[0] = nloc; b.st[1] = nx; }
        const unsigned old = xb_add(&bar[XB_XSUB(b.x)], 1u);
        const unsigned gen = old / nloc;
        if (old + 1u == (gen + 1u) * nloc) {
            __builtin_amdgcn_fence(__ATOMIC_RELEASE, "agent");
            asm volatile("s_waitcnt vmcnt(0)" ::: "memory");
            const unsigned og = xb_add(&bar[XB_TOP], 1u);
            const unsigned tg = og / nx;
            if (og + 1u == (tg + 1u) * nx) xb_add(&bar[XB_TOPGEN], 1u);
            else XB_SPIN(xb_ld(&bar[XB_TOPGEN]) == tg, bar);
            __builtin_amdgcn_fence(__ATOMIC_ACQUIRE, "agent");
            xb_add(&bar[XB_XGEN(b.x)], 1u);
            asm volatile("s_waitcnt vmcnt(0)" ::: "memory");
        } else {
            XB_SPIN(xb_ld(&bar[XB_XGEN(b.x)]) == gen, bar);
            __builtin_amdgcn_fence(__ATOMIC_ACQUIRE, "agent");
            asm volatile("s_waitcnt vmcnt(0)" ::: "memory");
        }
    }
    __syncthreads();
}


constexpr int LDS_BYTES = 128 * 1024 + 256;
#ifndef NREP_ATT
#define NREP_ATT 1
#endif
#ifndef NREP_G1
#define NREP_G1 1
#endif
#ifndef NREP_G3
#define NREP_G3 1
#endif


#ifdef PROBE_E
#define PROBE_SYNC grid.sync(); __builtin_amdgcn_fence(__ATOMIC_ACQUIRE, "agent"); asm volatile("s_waitcnt vmcnt(0)" ::: "memory");
#else
#define PROBE_SYNC
#endif
__global__ void __launch_bounds__(512, 2) fwd_megakernel(Params P) {
    extern __shared__ __attribute__((aligned(16))) unsigned char lds[];
    cg::grid_group grid = cg::this_grid();
    unsigned char* ws = P.ws;
    const float* MOD = (const float*)(ws + W_MOD);
    bf16_t* H = (bf16_t*)(ws + W_R1);
    float* Y = P.out;
    const int G = gridDim.x, bx = blockIdx.x;
    pg8::StaticOrder S;
    volatile LAS unsigned* xst = (volatile LAS unsigned*)((LAS unsigned char*)lds + 128 * 1024);
    if (threadIdx.x < 2) xst[threadIdx.x] = 0u;
    __syncthreads();
    XcdBarrier xbar = xcd_barrier_post((unsigned*)(ws + W_BAR), xst);
#define GSYNC() xcd_barrier(xbar)

#ifndef NO_P0
    p0_prologue(P, lds);
#endif
    if (gridDim.x > 65536u) grid.sync();
    GSYNC();
    norm_phase(P.in[0], P.in[1] - (size_t)TC * 1024, P.in[9], MOD, 0, H);
    p1_aux(P);
    GSYNC();

    { pg8::Gemm g{H, (const bf16_t*)(ws + W_WIN), T, 2304, 1024}; S.init(T, 2304, G, bx);
      pg8::EpiProj E{(bf16_t*)(ws + W_CQ), (bf16_t*)(ws + W_CKV), (bf16_t*)((unsigned char*)P.out + OS_PB), PB_LD, (float*)(ws + W_RS) + 3 * T, (float*)(ws + W_RS) + 4 * T};
      pg8::gemm_phase((LAS unsigned char*)lds, g, S, E); }
    GSYNC();
    { pg8::Gemm g{(const bf16_t*)(ws + W_CQ), (const bf16_t*)(ws + W_WUQ), T, 768, 384}; S.init(T, 768, G, bx);
      pg8::EpiBf16Scaled E{(bf16_t*)(ws + W_QRAW), 768, (const float*)(ws + W_RS) + 3 * T, 1.f / 384.f, T};
      pg8::gemm_phase((LAS unsigned char*)lds, g, S, E); }
    { pg8::Gemm g{(const bf16_t*)(ws + W_CKV), (const bf16_t*)(ws + W_WUKV), TK, 1024, 256}; S.init(TK, 1024, G, G - 1 - bx);
      pg8::EpiBf16Scaled E{(bf16_t*)(ws + W_KVRAW), 1024, (const float*)(ws + W_RS) + 4 * T, 1.f / 256.f, T};
      pg8::gemm_phase((LAS unsigned char*)lds, g, S, E); }
    GSYNC();
#ifndef NO_P5
    p5_qknorm(P, lds);
#endif
#ifndef NO_G1
    { int nrep = NREP_G1; asm volatile("" : "+s"(nrep));
#pragma unroll 1
      for (int rep = 0; rep < nrep; ++rep) gla_pass1(P, lds); }
#endif
    GSYNC();
#ifdef STOP5
    return;
#endif
#ifndef NO_G2
    gla_pass2(P);
#endif
    GSYNC();
#ifdef STOP6
    for (size_t i = (size_t)blockIdx.x * 512 + threadIdx.x; i < (size_t)T * 256; i += (size_t)gridDim.x * 512) ((f32x4*)Y)[i] = (f32x4){0.f, 0.f, 0.f, 0.f};
    return;
#endif
#ifndef NO_AT
    { int nrep = NREP_ATT; asm volatile("" : "+s"(nrep));
#pragma unroll 1
      for (int rep = 0; rep < nrep; ++rep) attn_phase(P, lds); }
#endif
#ifndef NO_G3
    { int nrep = NREP_G3; asm volatile("" : "+s"(nrep));
#pragma unroll 1
      for (int rep = 0; rep < nrep; ++rep) gla_pass3(P, lds); }
#endif
    GSYNC();

    bf16_t* XS = (bf16_t*)(ws + W_XS); const float* GMp = (const float*)(ws + W_GM); float* RSp = (float*)(ws + W_RS); const float* NBp = (const float*)(ws + W_NB);
    bf16_t* ACT = (bf16_t*)(ws + W_R1);
    { pg8::Gemm g{(const bf16_t*)(ws + W_R1), (const bf16_t*)(ws + W_WOUT), T, 1024, 1024}; S.init(T, 1024, G, bx);
      pg8::EpiResGate E{Y, P.in[0], P.in[1] - (size_t)TC * 1024, MOD, 0 * 6 + 2, nullptr, XS, GMp, RSp};
      pg8::gemm_phase((LAS unsigned char*)lds, g, S, E); }
    GSYNC();
    { pg8::Gemm g{XS, (const bf16_t*)(ws + W_WGU), T, 5632, 1024}; S.init(T, 5632, G, bx);
      pg8::EpiGated<0> E{ACT, FFN, NBp, RSp};
      pg8::gemm_phase((LAS unsigned char*)lds, g, S, E); }
    GSYNC();
    { pg8::Gemm g{ACT, (const bf16_t*)(ws + W_WDN), T, 1024, FFN}; S.init(T, 1024, G, bx);
      pg8::EpiResGate E{Y, Y, Y, MOD, 0 * 6 + 5, nullptr, XS, GMp + 5120, RSp + T};
      pg8::gemm_phase((LAS unsigned char*)lds, g, S, E); }
    GSYNC();
    { pg8::Gemm g{XS, (const bf16_t*)(ws + W_WPW1), T, 2048, 1024}; S.init(T, 2048, G, bx);
      pg8::EpiGated<1> E{ACT, 1024, NBp + 5632, RSp + T};
      pg8::gemm_phase((LAS unsigned char*)lds, g, S, E); }
    GSYNC();
    dwconv_phase(P, lds);
    GSYNC();
    { pg8::Gemm g{ACT + (size_t)T * 1024, (const bf16_t*)(ws + W_WPW2), T, 1024, 1024}; S.init(T, 1024, G, bx);
      pg8::EpiResGate E{Y, Y, Y, MOD, 6 + 2, P.in[29], XS, GMp + 2 * 5120, RSp + 2 * T};
      pg8::gemm_phase((LAS unsigned char*)lds, g, S, E); }
    GSYNC();
    { pg8::Gemm g{XS, (const bf16_t*)(ws + W_WGU) + (size_t)5632 * 1024, T, 5632, 1024}; S.init(T, 5632, G, bx);
      pg8::EpiGated<0> E{ACT, FFN, NBp + 7680, RSp + 2 * T};
      pg8::gemm_phase((LAS unsigned char*)lds, g, S, E); }
    GSYNC();
    { pg8::Gemm g{ACT, (const bf16_t*)(ws + W_WDN) + (size_t)1024 * FFN, T, 1024, FFN}; S.init(T, 1024, G, bx);
      pg8::EpiResGate E{Y, Y, Y, MOD, 6 + 5, nullptr, nullptr, nullptr, nullptr};
      pg8::gemm_phase((LAS unsigned char*)lds, g, S, E); }
}

extern "C" void kernel_launch(void* const* d_in, const int* in_sizes, int n_in, void* d_out, int out_size, void* d_ws, size_t ws_size, hipStream_t stream) {
    static int grid_blocks = 0;
    if (!grid_blocks) {
        int dev = 0, cus = 0, per_cu = 0;
        hipGetDevice(&dev);
        hipDeviceGetAttribute(&cus, hipDeviceAttributeMultiprocessorCount, dev);
        hipFuncSetAttribute((const void*)fwd_megakernel, hipFuncAttributeMaxDynamicSharedMemorySize, LDS_BYTES);
        hipOccupancyMaxActiveBlocksPerMultiprocessor(&per_cu, (const void*)fwd_megakernel, 512, LDS_BYTES);
        if (per_cu < 1) { fprintf(stderr, "occupancy query: %d blocks per CU\n", per_cu); per_cu = 1; }
        if (per_cu > 1) per_cu = 1;
        grid_blocks = cus * per_cu;
        if (n_in != 33 || ws_size < W_END) fprintf(stderr, "unexpected n_in %d / ws_size %zu\n", n_in, ws_size);
    }
    Params p{};
    for (int i = 0; i < 33; ++i) p.in[i] = (const float*)d_in[i];
    p.out = (float*)d_out; p.ws = (unsigned char*)d_ws;
    (void)hipMemsetAsync((unsigned char*)d_ws + W_BAR, 0, XCD_BAR_WORDS * 4, stream);
    void* args[] = {&p};
    hipError_t e = hipLaunchCooperativeKernel((const void*)fwd_megakernel, dim3(grid_blocks), dim3(512), args, LDS_BYTES, stream);
    if (e != hipSuccess) fprintf(stderr, "cooperative launch failed: %s (grid %d)\n", hipGetErrorString(e), grid_blocks);
}
```
